# Optimizing an MI355X kernel written in HIP

```python
import jax, jax.numpy as jnp
from jax import lax
import numpy as np

D_MODEL = 1024
BATCH = 8
SEQ = 8192
DEPTH = 2

N_MIXERS = 2
EPS = 1e-6
GLA_HEADS = 4
GLA_DK = D_MODEL // 2 // GLA_HEADS
GLA_DV = D_MODEL // GLA_HEADS
GLA_GATE_RANK = 16
GLA_GATE_TAU = 16.0
GLA_CHUNK = 64
GLA_IN = 2 * GLA_HEADS * GLA_DK + GLA_HEADS * GLA_DV + GLA_GATE_RANK + GLA_HEADS * GLA_DV
MLA_HEADS = 8
MLA_NOPE = 128
MLA_ROPE = 64
MLA_V = D_MODEL // MLA_HEADS
MLA_Q_LORA = D_MODEL // 4
MLA_KV_LORA = D_MODEL // 8
MLA_IN = MLA_Q_LORA + MLA_KV_LORA + MLA_ROPE
MLA_SCALE = (MLA_NOPE + MLA_ROPE) ** -0.5
ROPE_THETA = 10000.0
Q_BLOCK = 128
MOE_GROUPS = 8
MOE_PER_GROUP = 8
MOE_EXPERTS = MOE_GROUPS * MOE_PER_GROUP
MOE_TOPK = 2
MOE_FF = D_MODEL // 4
MOE_BLOCK = 128

kernel_name = 'hybrid_gla_mla_hier_moe'


def rmsnorm(x, g):
    x32 = x.astype(jnp.float32)
    y = x32 * lax.rsqrt(jnp.mean(x32 * x32, axis=-1, keepdims=True) + EPS)
    return (y * g.astype(jnp.float32)).astype(x.dtype)


def rope_tables(positions):
    inv_freq = 1.0 / (ROPE_THETA ** (jnp.arange(0, MLA_ROPE, 2, dtype=jnp.float32) / MLA_ROPE))
    ang = positions.astype(jnp.float32)[..., None] * inv_freq
    return jnp.cos(ang), jnp.sin(ang)


def apply_rope(t, cos, sin):
    t32 = t.astype(jnp.float32)
    t1, t2 = jnp.split(t32, 2, axis=-1)
    return jnp.concatenate([t1 * cos - t2 * sin, t2 * cos + t1 * sin], axis=-1).astype(t.dtype)


def gla_mixer(h, w_in, w_gate, b_gate, out_norm, w_o):
    bsz, seq, _ = h.shape
    nc = seq // GLA_CHUNK
    qk = GLA_HEADS * GLA_DK
    vd = GLA_HEADS * GLA_DV
    proj = h @ w_in
    q, k, v, a_lr, r = jnp.split(proj, [qk, 2 * qk, 2 * qk + vd, 2 * qk + vd + GLA_GATE_RANK], axis=-1)
    log_a = jax.nn.log_sigmoid((a_lr @ w_gate + b_gate).astype(jnp.float32)) / GLA_GATE_TAU

    def chunks(t, d):
        return t.reshape(bsz, nc, GLA_CHUNK, GLA_HEADS, d).transpose(0, 3, 1, 2, 4).astype(jnp.float32)

    qc = chunks(q, GLA_DK) * (GLA_DK ** -0.5)
    kc = chunks(k, GLA_DK)
    vc = chunks(v, GLA_DV)
    g = jnp.cumsum(chunks(log_a, GLA_DK), axis=3)
    g_mid = g[:, :, :, GLA_CHUNK // 2:GLA_CHUNK // 2 + 1]
    g_last = g[:, :, :, -1:]
    causal = jnp.tril(jnp.ones((GLA_CHUNK, GLA_CHUNK), dtype=bool))
    a_intra = jnp.einsum('bhnid,bhnjd->bhnij', qc * jnp.exp(g - g_mid), kc * jnp.exp(g_mid - g))
    o_intra = jnp.einsum('bhnij,bhnjv->bhniv', jnp.where(causal, a_intra, 0.0), vc)
    q_inter = jnp.moveaxis(qc * jnp.exp(g), 2, 0)
    k_state = jnp.moveaxis(kc * jnp.exp(g_last - g), 2, 0)
    decay = jnp.moveaxis(jnp.exp(g_last[:, :, :, 0]), 2, 0)
    v_s = jnp.moveaxis(vc, 2, 0)

    def step(state, inp):
        q_i, k_i, v_i, d_i = inp
        o_i = jnp.einsum('bhid,bhdv->bhiv', q_i, state)
        state = state * d_i[..., None] + jnp.einsum('bhjd,bhjv->bhdv', k_i, v_i)
        return state, o_i

    s0 = jnp.zeros((bsz, GLA_HEADS, GLA_DK, GLA_DV), jnp.float32)
    _, o_inter = lax.scan(step, s0, (q_inter, k_state, v_s, decay))
    o = o_intra + jnp.moveaxis(o_inter, 0, 2)
    o = o.transpose(0, 2, 3, 1, 4).reshape(bsz, seq, GLA_HEADS, GLA_DV)
    o = o * lax.rsqrt(jnp.mean(o * o, axis=-1, keepdims=True) + EPS) * out_norm.astype(jnp.float32)
    o = o.reshape(bsz, seq, vd) * jax.nn.silu(r.astype(jnp.float32))
    return o.astype(h.dtype) @ w_o


def mla_mixer(h, cos, sin, w_in, q_norm, w_uq, kv_norm, w_uk, w_uv, w_o):
    bsz, seq, _ = h.shape
    nqb = seq // Q_BLOCK
    proj = h @ w_in
    c_q, c_kv, k_rope = jnp.split(proj, [MLA_Q_LORA, MLA_Q_LORA + MLA_KV_LORA], axis=-1)
    c_q = rmsnorm(c_q, q_norm)
    c_kv = rmsnorm(c_kv, kv_norm)
    q = jnp.einsum('bsc,chd->bshd', c_q, w_uq)
    q_nope, q_rope = q[..., :MLA_NOPE], q[..., MLA_NOPE:]
    q_rope = apply_rope(q_rope, cos[:, :, None, :], sin[:, :, None, :])
    k_rope = apply_rope(k_rope, cos, sin)
    q_lat = jnp.einsum('bshn,chn->bshc', q_nope, w_uk)
    q_cat = jnp.concatenate([q_lat, q_rope], axis=-1) * MLA_SCALE
    k_cat = jnp.concatenate([c_kv, k_rope], axis=-1)
    q_blocks = q_cat.reshape(bsz, nqb, Q_BLOCK, MLA_HEADS, MLA_KV_LORA + MLA_ROPE).transpose(1, 0, 2, 3, 4)
    k_pos = jnp.arange(seq)

    def attend(args):
        q_b, b_idx = args
        s = jnp.einsum('bqhc,bkc->bhqk', q_b, k_cat).astype(jnp.float32)
        q_pos = b_idx * Q_BLOCK + jnp.arange(Q_BLOCK)
        s = jnp.where(k_pos[None, :] <= q_pos[:, None], s, -jnp.inf)
        p = jax.nn.softmax(s, axis=-1).astype(c_kv.dtype)
        return jnp.einsum('bhqk,bkc->bqhc', p, c_kv)

    o_lat = lax.map(attend, (q_blocks, jnp.arange(nqb)))
    o_lat = o_lat.transpose(1, 0, 2, 3, 4).reshape(bsz, seq, MLA_HEADS, MLA_KV_LORA)
    o = jnp.einsum('bshc,chv->bshv', o_lat, w_uv).reshape(bsz, seq, MLA_HEADS * MLA_V)
    return o @ w_o


def hier_moe(h, w_group, w_expert, w1, w3, w2):
    bsz, seq, dm = h.shape
    n_tok = bsz * seq
    xf = h.reshape(n_tok, dm)
    tok = jnp.arange(n_tok)
    g_logits = (xf @ w_group).astype(jnp.float32)
    g_prob = jax.nn.softmax(g_logits, axis=-1)
    g_sel = jnp.argmax(g_logits, axis=-1)
    g_w = g_prob[tok, g_sel]
    e_logits = (xf @ w_expert).astype(jnp.float32).reshape(n_tok, MOE_GROUPS, MOE_PER_GROUP)
    e_prob = jax.nn.softmax(e_logits[tok, g_sel], axis=-1)
    top_p, top_i = lax.top_k(e_prob, MOE_TOPK)
    gates = g_w[:, None] * top_p / jnp.sum(top_p, axis=-1, keepdims=True)
    expert_id = g_sel[:, None] * MOE_PER_GROUP + top_i
    n_asg = n_tok * MOE_TOPK
    flat_e = expert_id.reshape(n_asg)
    flat_tok = jnp.arange(n_asg) // MOE_TOPK
    flat_gate = gates.reshape(n_asg)
    order = jnp.argsort(flat_e)
    se, stok, sgate = flat_e[order], flat_tok[order], flat_gate[order]
    counts = jax.ops.segment_sum(jnp.ones_like(flat_e), flat_e, num_segments=MOE_EXPERTS)
    starts = jnp.cumsum(counts) - counts
    padded = (counts + MOE_BLOCK - 1) // MOE_BLOCK * MOE_BLOCK
    pend = jnp.cumsum(padded)
    pstarts = pend - padded
    dest = pstarts[se] + (jnp.arange(n_asg) - starts[se])
    n_slots = n_asg + MOE_EXPERTS * MOE_BLOCK
    n_blocks = n_slots // MOE_BLOCK
    slot_tok = jnp.full((n_slots,), n_tok, dtype=jnp.int32).at[dest].set(stok.astype(jnp.int32))
    slot_gate = jnp.zeros((n_slots,), jnp.float32).at[dest].set(sgate)
    block_e = jnp.minimum(jnp.searchsorted(pend, jnp.arange(n_blocks) * MOE_BLOCK, side='right'), MOE_EXPERTS - 1)
    x_pad = jnp.concatenate([xf, jnp.zeros((1, dm), xf.dtype)], axis=0)
    xs = x_pad[slot_tok].reshape(n_blocks, MOE_BLOCK, dm)

    def expert_block(args):
        xb, e = args
        hid = jax.nn.silu(xb @ w1[e]) * (xb @ w3[e])
        return hid @ w2[e]

    ys = lax.map(expert_block, (xs, block_e)).reshape(n_slots, dm)
    ys = ys * slot_gate[:, None].astype(ys.dtype)
    out = jnp.zeros((n_tok + 1, dm), ys.dtype).at[slot_tok].add(ys)[:n_tok]
    return out.reshape(bsz, seq, dm)


def setup_inputs(seed: int = 0) -> dict:
    key = jax.random.key(seed)
    ks = jax.random.split(key, 24)
    f32 = jnp.float32
    n_gla = (DEPTH + N_MIXERS - 1) // N_MIXERS
    n_mla = DEPTH // N_MIXERS

    def nrm(k, shape, fan_in):
        return jax.random.normal(k, shape, f32) * (fan_in ** -0.5)

    def gain(k, shape):
        return 1.0 + 0.1 * jax.random.normal(k, shape, f32)

    x = jax.random.normal(ks[0], (BATCH, SEQ, D_MODEL), f32)
    offsets = jax.random.randint(ks[1], (BATCH, 1), 0, 4096, dtype=jnp.int32)
    positions = offsets + jnp.arange(SEQ, dtype=jnp.int32)[None, :]
    return {
        'x': x,
        'positions': positions,
        'attn_norm': gain(ks[2], (DEPTH, D_MODEL)),
        'ffn_norm': gain(ks[3], (DEPTH, D_MODEL)),
        'final_norm': gain(ks[4], (D_MODEL,)),
        'gla_w_in': nrm(ks[5], (n_gla, D_MODEL, GLA_IN), D_MODEL),
        'gla_w_gate': nrm(ks[6], (n_gla, GLA_GATE_RANK, GLA_HEADS * GLA_DK), GLA_GATE_RANK),
        'gla_b_gate': 0.1 * jax.random.normal(ks[7], (n_gla, GLA_HEADS * GLA_DK), f32),
        'gla_out_norm': gain(ks[8], (n_gla, GLA_DV)),
        'gla_w_o': nrm(ks[9], (n_gla, GLA_HEADS * GLA_DV, D_MODEL), GLA_HEADS * GLA_DV),
        'mla_w_in': nrm(ks[10], (n_mla, D_MODEL, MLA_IN), D_MODEL),
        'mla_q_norm': gain(ks[11], (n_mla, MLA_Q_LORA)),
        'mla_w_uq': nrm(ks[12], (n_mla, MLA_Q_LORA, MLA_HEADS, MLA_NOPE + MLA_ROPE), MLA_Q_LORA),
        'mla_kv_norm': gain(ks[13], (n_mla, MLA_KV_LORA)),
        'mla_w_uk': nrm(ks[14], (n_mla, MLA_KV_LORA, MLA_HEADS, MLA_NOPE), MLA_KV_LORA),
        'mla_w_uv': nrm(ks[15], (n_mla, MLA_KV_LORA, MLA_HEADS, MLA_V), MLA_KV_LORA),
        'mla_w_o': nrm(ks[16], (n_mla, MLA_HEADS * MLA_V, D_MODEL), MLA_HEADS * MLA_V),
        'moe_w_group': nrm(ks[17], (DEPTH, D_MODEL, MOE_GROUPS), D_MODEL),
        'moe_w_expert': nrm(ks[18], (DEPTH, D_MODEL, MOE_EXPERTS), D_MODEL),
        'moe_w1': nrm(ks[19], (DEPTH, MOE_EXPERTS, D_MODEL, MOE_FF), D_MODEL),
        'moe_w3': nrm(ks[20], (DEPTH, MOE_EXPERTS, D_MODEL, MOE_FF), D_MODEL),
        'moe_w2': nrm(ks[21], (DEPTH, MOE_EXPERTS, MOE_FF, D_MODEL), MOE_FF),
    }


def reference(x, positions, attn_norm, ffn_norm, final_norm,
              gla_w_in, gla_w_gate, gla_b_gate, gla_out_norm, gla_w_o,
              mla_w_in, mla_q_norm, mla_w_uq, mla_kv_norm, mla_w_uk, mla_w_uv, mla_w_o,
              moe_w_group, moe_w_expert, moe_w1, moe_w3, moe_w2):
    cos, sin = rope_tables(positions)
    for i in range(DEPTH):
        j = i // N_MIXERS
        h = rmsnorm(x, attn_norm[i])
        if i % N_MIXERS == 0:
            m = gla_mixer(h, gla_w_in[j], gla_w_gate[j], gla_b_gate[j], gla_out_norm[j], gla_w_o[j])
        else:
            m = mla_mixer(h, cos, sin, mla_w_in[j], mla_q_norm[j], mla_w_uq[j], mla_kv_norm[j],
                          mla_w_uk[j], mla_w_uv[j], mla_w_o[j])
        x = x + m.astype(x.dtype)
        h = rmsnorm(x, ffn_norm[i])
        x = x + hier_moe(h, moe_w_group[i], moe_w_expert[i], moe_w1[i], moe_w3[i], moe_w2[i]).astype(x.dtype)
    return rmsnorm(x, final_norm)
```

```cpp
#include <hip/hip_runtime.h>
#include <stdint.h>
#include <stdio.h>

typedef unsigned short bf16_t;
typedef short bf16x8 __attribute__((ext_vector_type(8)));
typedef short s16x4 __attribute__((ext_vector_type(4)));
typedef float f32x4 __attribute__((ext_vector_type(4)));
typedef float f32x16 __attribute__((ext_vector_type(16)));
typedef unsigned u32x2 __attribute__((ext_vector_type(2)));
typedef unsigned u32x4 __attribute__((ext_vector_type(4)));

#define XB_TMO      128
#define XB_XCNT(j)  (256  + 64 * (j))
#define XB_XSUB(j)  (1280 + 64 * (j))
#define XB_XGEN(j)  (2304 + 64 * (j))
#define XB_TOP      3328
#define XB_TOPGEN   3392
#define XCD_BAR_WORDS 3456
#define XB_SPIN_CAP (1u << 18)
#define LAS __attribute__((address_space(3)))

__device__ __forceinline__ unsigned xb_ld(unsigned* p)              { return __hip_atomic_load(p, __ATOMIC_RELAXED, __HIP_MEMORY_SCOPE_AGENT); }
__device__ __forceinline__ unsigned xb_add(unsigned* p, unsigned v) { return __hip_atomic_fetch_add(p, v, __ATOMIC_RELAXED, __HIP_MEMORY_SCOPE_AGENT); }
__device__ __forceinline__ unsigned xb_xcc_id() { return (unsigned)__builtin_amdgcn_s_getreg((3 << 11) | 20) & 0xFu; }
#define XB_SPIN(cond, bar) do { unsigned _sp = 0; while (cond) { __builtin_amdgcn_s_sleep(1); \
    if ((++_sp & 255u) == 0u) { if (xb_ld(&(bar)[XB_TMO])) break; if (_sp > XB_SPIN_CAP) { atomicAdd(&(bar)[XB_TMO], 1u); break; } } } } while (0)

struct XcdBarrier { unsigned* bar; unsigned x; volatile LAS unsigned* st; };

__device__ __forceinline__ XcdBarrier xcd_barrier_post(unsigned* bar, volatile LAS unsigned* st) {
    XcdBarrier b; b.bar = bar; b.x = xb_xcc_id(); b.st = st;
    if (threadIdx.x == 0) (void)xb_add(&bar[XB_XCNT(b.x)], 1u);
    return b;
}
__device__ __forceinline__ void xcd_barrier_complete(unsigned* bar, unsigned x, unsigned& nloc, unsigned& nx) {
    const unsigned G = gridDim.x * gridDim.y * gridDim.z;
    unsigned sum, cnt, mine, sp = 0u;
    for (;;) {
        sum = 0u; cnt = 0u; mine = 0u;
#pragma unroll
        for (unsigned j = 0; j < 16; ++j) { const unsigned c = xb_ld(&bar[XB_XCNT(j)]); sum += c; cnt += (c > 0u) ? 1u : 0u; mine = (j == x) ? c : mine; }
        if (sum == G) break;
        __builtin_amdgcn_s_sleep(1);
        if ((++sp & 255u) == 0u) { if (xb_ld(&bar[XB_TMO])) break; if (sp > XB_SPIN_CAP) { atomicAdd(&bar[XB_TMO], 1u); break; } }
    }
    nloc = mine > 0u ? mine : 1u; nx = cnt > 0u ? cnt : 1u;
}
__device__ __forceinline__ void xcd_barrier(const XcdBarrier& b) {
    asm volatile("s_waitcnt vmcnt(0)" ::: "memory");
    __syncthreads();
    if (threadIdx.x == 0) {
        unsigned* bar = b.bar;
        __builtin_amdgcn_s_waitcnt(0);
        unsigned nloc = b.st[0], nx = b.st[1];
        if (nloc == 0u) { xcd_barrier_complete(bar, b.x, nloc, nx); b.st[0] = nloc; b.st[1] = nx; }
        const unsigned old = xb_add(&bar[XB_XSUB(b.x)], 1u);
        const unsigned gen = old / nloc;
        if (old + 1u == (gen + 1u) * nloc) {
            __builtin_amdgcn_fence(__ATOMIC_RELEASE, "agent");
            asm volatile("s_waitcnt vmcnt(0)" ::: "memory");
            const unsigned og = xb_add(&bar[XB_TOP], 1u);
            const unsigned tg = og / nx;
            if (og + 1u == (tg + 1u) * nx) xb_add(&bar[XB_TOPGEN], 1u);
            else XB_SPIN(xb_ld(&bar[XB_TOPGEN]) == tg, bar);
            __builtin_amdgcn_fence(__ATOMIC_ACQUIRE, "agent");
            xb_add(&bar[XB_XGEN(b.x)], 1u);
            asm volatile("s_waitcnt vmcnt(0)" ::: "memory");
        } else {
            XB_SPIN(xb_ld(&bar[XB_XGEN(b.x)]) == gen, bar);
            __builtin_amdgcn_fence(__ATOMIC_ACQUIRE, "agent");
            asm volatile("s_waitcnt vmcnt(0)" ::: "memory");
        }
    }
    __syncthreads();
}

#define NTOK 65536
#define SEQL 8192
#define EPSF 1e-6f

constexpr size_t MB = (size_t)1 << 20;
constexpr size_t OFF_R     = 1 * MB;
constexpr size_t OFF_HB    = 257 * MB;
constexpr size_t OFF_BIG   = 385 * MB;
constexpr size_t OFF_WT    = 769 * MB;
constexpr size_t OFF_GLAIN = OFF_WT;
constexpr size_t OFF_GLAWO = OFF_WT + 7 * MB;
constexpr size_t OFF_MLAIN = OFF_WT + 9 * MB;
constexpr size_t OFF_QABS  = OFF_WT + 10 * MB;
constexpr size_t OFF_UVO   = OFF_WT + 11 * MB;
constexpr size_t OFF_ROUT  = OFF_WT + 13 * MB;
constexpr size_t OFF_MOE13 = 783 * MB;
constexpr size_t OFF_MOE2  = 847 * MB;
constexpr size_t OFF_ALR   = 879 * MB;
constexpr size_t OFF_EG    = 883 * MB;
constexpr size_t OFF_EM    = 885 * MB;
constexpr size_t OFF_EL    = 887 * MB;
constexpr size_t OFF_SLOC  = 889 * MB;
constexpr size_t OFF_DSEG  = 921 * MB;
constexpr size_t OFF_LISTS = 922 * MB;
constexpr size_t OFF_GATES = 938 * MB;
constexpr size_t OFF_CS    = 939 * MB;
constexpr size_t OFF_RSTD  = 955 * MB;
constexpr size_t OFF_LRSTD = OFF_R + 128 * MB;
constexpr size_t OFF_SLOT  = 956 * MB;
constexpr size_t WS_NEED   = 958 * MB;
constexpr size_t BIG_QCAT = 0;
constexpr size_t BIG_KCAT = 192 * MB;
constexpr size_t BIG_OLAT = 216 * MB;
constexpr size_t BIG_TMP  = 216 * MB;
#define CTRL_GCNT 4096

struct Params {
    const float* x; const int* pos; const float* attn_norm; const float* ffn_norm; const float* final_norm;
    const float* gla_w_in; const float* gla_w_gate; const float* gla_b_gate; const float* gla_out_norm; const float* gla_w_o;
    const float* mla_w_in; const float* mla_q_norm; const float* mla_w_uq; const float* mla_kv_norm; const float* mla_w_uk; const float* mla_w_uv; const float* mla_w_o;
    const float* moe_w_group; const float* moe_w_expert; const float* moe_w1; const float* moe_w3; const float* moe_w2;
    float* out; char* ws;
};

typedef const __attribute__((address_space(4))) Params* KArgP;
__device__ __forceinline__ int ftid() { int t = (int)threadIdx.x; asm volatile("" : "+v"(t)); return t; }
__device__ __forceinline__ unsigned cvt_pk(float lo, float hi) { unsigned r; asm("v_cvt_pk_bf16_f32 %0, %1, %2" : "=v"(r) : "v"(lo), "v"(hi)); return r; }
__device__ __forceinline__ float bf_lo(unsigned w) { return __uint_as_float(w << 16); }
__device__ __forceinline__ float bf_hi(unsigned w) { return __uint_as_float(w & 0xffff0000u); }
__device__ __forceinline__ float bf2f(bf16_t v) { return __uint_as_float(((unsigned)v) << 16); }
__device__ __forceinline__ float wave_sum(float v) {
#pragma unroll
    for (int o = 32; o >= 1; o >>= 1) v += __shfl_xor(v, o);
    return v;
}
__device__ __forceinline__ float silu_f(float x) { return x * __builtin_amdgcn_rcpf(1.0f + __expf(-x)); }
typedef LAS s16x4 lds_s16x4;
typedef LAS char lchar;
__device__ __forceinline__ s16x4 tr16(const lchar* p) { return __builtin_amdgcn_ds_read_tr16_b64_v4i16((lds_s16x4*)p); }
__device__ __forceinline__ lchar* opq(lchar* p) { unsigned v = (unsigned)(size_t)p; asm("" : "+v"(v)); return (lchar*)(size_t)v; }
template <class T> __device__ __forceinline__ T ldsr(const lchar* p) { return *(const LAS T*)p; }
template <class T> __device__ __forceinline__ void ldsw(lchar* p, T v) { *(LAS T*)p = v; }
__device__ __forceinline__ bf16x8 cat8(s16x4 a, s16x4 b) { return __builtin_shufflevector(a, b, 0, 1, 2, 3, 4, 5, 6, 7); }
__device__ __forceinline__ f32x16 mfma32(bf16x8 a, bf16x8 b, f32x16 c) { return __builtin_amdgcn_mfma_f32_32x32x16_bf16(a, b, c, 0, 0, 0); }
__device__ __forceinline__ f32x4 mfma16(bf16x8 a, bf16x8 b, f32x4 c) { return __builtin_amdgcn_mfma_f32_16x16x32_bf16(a, b, c, 0, 0, 0); }

struct CvTile { const float* src; const float* kgain; bf16_t* dst; int ld, ldd, mode, which, k0, n0, nvalid, row0; };
constexpr int CV_DENSE_TILES = 73 * 16, CV_MOE_TILES = 64 * 192;
__device__ __forceinline__ CvTile cv_tile(KArgP p, int set, int t) {
    CvTile m; m.kgain = nullptr; m.mode = 0; m.which = 0; m.row0 = 0; m.nvalid = 1 << 20;
    if (set == 0 && t < CV_DENSE_TILES) {
        const int nt = t >> 4; m.k0 = (t & 15) * 64; m.ldd = 1024;
        if (nt < 49) {
            m.ld = 3088; m.dst = (bf16_t*)(p->ws + OFF_GLAIN);
            if (nt < 32)      { m.src = p->gla_w_in;        m.n0 = nt * 64; }
            else if (nt < 48) { m.src = p->gla_w_in + 2064; m.n0 = (nt - 32) * 64; m.row0 = 2048; }
            else              { m.src = p->gla_w_in + 2048; m.n0 = 0; m.row0 = 3072; m.nvalid = 16; }
        } else if (nt < 65)   { m.src = p->gla_w_o; m.ld = 1024; m.dst = (bf16_t*)(p->ws + OFF_GLAWO); m.n0 = (nt - 49) * 64; }
        else                  { m.src = p->mla_w_in; m.ld = 448; m.dst = (bf16_t*)(p->ws + OFF_MLAIN); m.n0 = (nt - 65) * 64; m.nvalid = 448;
                                m.kgain = p->attn_norm + 1024; if (nt - 65 == 6) m.mode = 2; }
        return m;
    }
    const int tm = set == 0 ? t - CV_DENSE_TILES : t, layer = set;
    const int e = tm / 192, r = tm % 192, kind = r >> 6, rr = r & 63;
    if (kind < 2) {
        const float* w1 = p->moe_w1; const float* w3 = p->moe_w3;
        m.src = (kind == 0 ? w1 : w3) + ((size_t)layer * 64 + e) * 1024 * 256; m.ld = 256;
        m.dst = (bf16_t*)(p->ws + OFF_MOE13) + (size_t)e * 512 * 1024; m.ldd = 1024; m.mode = 1; m.which = kind; m.k0 = (rr >> 2) * 64; m.n0 = (rr & 3) * 64;
        m.kgain = p->ffn_norm + layer * 1024;
    } else {
        m.src = p->moe_w2 + ((size_t)layer * 64 + e) * 256 * 1024; m.ld = 1024;
        m.dst = (bf16_t*)(p->ws + OFF_MOE2) + (size_t)e * 1024 * 256; m.ldd = 256; m.k0 = (rr >> 4) * 64; m.n0 = (rr & 15) * 64;
    }
    return m;
}
#define CV_LOAD(V, G0, G1, D) { \
    const bool ok_ = (D).n0 + c < (D).nvalid; const int col_ = ok_ ? (D).n0 + c : 0; \
    const float* gp_ = ((D).kgain ? (D).kgain : p->ffn_norm) + (D).k0 + l7 * 8; const bool hg_ = (D).kgain != nullptr; \
    const float* sp_ = (D).src + (size_t)((D).k0 + kr) * (D).ld + col_; \
    _Pragma("unroll") for (int q = 0; q < 16; ++q) { const f32x4 x_ = *(const f32x4*)(sp_ + (size_t)(4 * q) * (D).ld); V[q] = ok_ ? x_ : f32x4{0.f, 0.f, 0.f, 0.f}; } \
    { const f32x4 a_ = *(const f32x4*)gp_, b_ = *(const f32x4*)(gp_ + 4); const f32x4 one_ = {1.f, 1.f, 1.f, 1.f}; G0 = hg_ ? a_ : one_; G1 = hg_ ? b_ : one_; } }
__device__ __forceinline__ void conv_run(KArgP p, int set, float* tile_all) {
    const int tid = ftid(), lane = tid & 63, wv = tid >> 6, kr = lane >> 4, c = (lane & 15) * 4, l7 = lane & 7, n8 = lane >> 3;
    float* tl = tile_all + wv * (64 * 65);
    const int NT = set == 0 ? CV_DENSE_TILES + CV_MOE_TILES : CV_MOE_TILES, GW = (int)gridDim.x * 8;
    int t = __builtin_amdgcn_readfirstlane((int)blockIdx.x * 8 + wv);
    __syncthreads();
    if (t < NT) {
        CvTile d = cv_tile(p, set, t);
        f32x4 v[16], g0, g1;
        CV_LOAD(v, g0, g1, d)
        for (; t < NT; t += GW) {
#pragma unroll
            for (int q = 0; q < 16; ++q) { float* d_ = tl + (kr + 4 * q) * 65 + c; d_[0] = v[q][0]; d_[1] = v[q][1]; d_[2] = v[q][2]; d_[3] = v[q][3]; }
            const CvTile me = d; const f32x4 h0 = g0, h1 = g1;
            d = cv_tile(p, set, __builtin_amdgcn_readfirstlane(t + GW < NT ? t + GW : t));
            CV_LOAD(v, g0, g1, d)
            asm volatile("" ::: "memory");
            const float* rp = tl + (l7 * 8) * 65 + n8;
            bf16_t* dp = me.dst + me.k0 + l7 * 8;
#pragma unroll
            for (int ps = 0; ps < 8; ++ps) {
                float f[8];
#pragma unroll
                for (int j = 0; j < 8; ++j) f[j] = rp[j * 65 + 8 * ps];
                const u32x4 w = {cvt_pk(f[0] * h0[0], f[1] * h0[1]), cvt_pk(f[2] * h0[2], f[3] * h0[3]), cvt_pk(f[4] * h1[0], f[5] * h1[1]), cvt_pk(f[6] * h1[2], f[7] * h1[3])};
                const int nn = me.n0 + n8 + 8 * ps;
                const int o2 = nn - me.n0;
                const int drow = me.mode == 1 ? ((nn >> 4) * 32 + me.which * 16 + (nn & 15)) : me.mode == 2 ? (me.n0 + ((o2 >> 4) & 1) * 32 + (o2 >> 5) * 16 + (o2 & 15)) : (me.row0 + nn);
                *(u32x4*)(dp + (size_t)drow * me.ldd) = w;
            }
            asm volatile("" ::: "memory");
        }
    }
    __syncthreads();
}
__device__ __forceinline__ void phase_weights(KArgP p, float* tile) {
    conv_run(p, 0, tile);
    const int gtid = blockIdx.x * 512 + ftid(), gstride = gridDim.x * 512;
    {
        bf16_t* br = (bf16_t*)(p->ws + OFF_ROUT);
        for (int i = gtid; i < 2 * 128 * 1024; i += gstride) {
            const int layer = i >> 17, n = (i >> 10) & 127, k = i & 1023;
            float v = 0.f;
            if (n < 8) v = p->moe_w_group[(size_t)layer * 1024 * 8 + k * 8 + n];
            else if (n < 72) v = p->moe_w_expert[(size_t)layer * 1024 * 64 + k * 64 + (n - 8)];
            v *= p->ffn_norm[layer * 1024 + k];
            br[i] = (bf16_t)(cvt_pk(v, 0.f) & 0xffffu);
        }
    }
    {
        bf16_t* bq = (bf16_t*)(p->ws + OFF_QABS);
        for (int idx = gtid; idx < 1536 * 256; idx += gstride) {
            const int row = idx >> 8, i = idx & 255; float s = 0.f;
            if (row < 1024) {
                const int h = row >> 7, c = row & 127;
                const f32x4* a = (const f32x4*)(p->mla_w_uq + (size_t)i * 1536 + h * 192);
                const f32x4* b = (const f32x4*)(p->mla_w_uk + (size_t)c * 1024 + h * 128);
#pragma unroll 8
                for (int n = 0; n < 32; ++n) { const f32x4 x = a[n], y = b[n]; s += x[0] * y[0] + x[1] * y[1] + x[2] * y[2] + x[3] * y[3]; }
            } else {
                const int rr = row - 1024, tile = rr >> 8, cl = rr & 255, bj = cl >> 7, wcc = (cl >> 5) & 3, half = (cl >> 4) & 1, lo = cl & 15;
                const int head = tile * 4 + 2 * bj + (wcc >> 1), jj = 16 * (wcc & 1) + lo;
                s = p->mla_w_uq[(size_t)i * 1536 + head * 192 + 128 + jj + 32 * half];
            }
            bq[idx] = (bf16_t)(cvt_pk(s, 0.f) & 0xffffu);
        }
    }
    {
        bf16_t* bo = (bf16_t*)(p->ws + OFF_UVO);
        const int t2 = 2 * ftid();
        for (int un = blockIdx.x; un < 256; un += gridDim.x) {
            const int h = un >> 5, c0 = (un & 31) * 4;
            const float* wo = p->mla_w_o + (size_t)(h * 128) * 1024 + t2;
            const float* wv = p->mla_w_uv + (size_t)c0 * 1024 + h * 128;
            float2 acc[4] = {{0.f, 0.f}, {0.f, 0.f}, {0.f, 0.f}, {0.f, 0.f}};
#pragma unroll 8
            for (int v = 0; v < 128; ++v) {
                const float2 x = *(const float2*)(wo + (size_t)v * 1024);
#pragma unroll
                for (int k = 0; k < 4; ++k) { const float u = wv[(size_t)k * 1024 + v]; acc[k].x += u * x.x; acc[k].y += u * x.y; }
            }
            u32x2 w0 = {cvt_pk(acc[0].x, acc[1].x), cvt_pk(acc[2].x, acc[3].x)}, w1 = {cvt_pk(acc[0].y, acc[1].y), cvt_pk(acc[2].y, acc[3].y)};
            *(u32x2*)(bo + (size_t)t2 * 1024 + h * 128 + c0) = w0; *(u32x2*)(bo + (size_t)(t2 + 1) * 1024 + h * 128 + c0) = w1;
        }
    }
    {
        float2* cs = (float2*)(p->ws + OFF_CS);
        for (int i = gtid; i < NTOK * 32; i += gstride) {
            const int t = i >> 5, j = i & 31;
            const float inv = exp2f(-(float)j * 0.41524101186092f);
            const float ang = (float)p->pos[t] * inv;
            double rev = (double)ang * 0.15915494309189535;
            rev = rev - __builtin_rint(rev);
            const float fr = (float)rev;
            cs[i] = make_float2(__builtin_amdgcn_cosf(fr), __builtin_amdgcn_sinf(fr));
        }
    }
}

template <bool ADD_Y, bool FINAL, bool SRC_BF, bool RSTD_ONLY = false>
__device__ __forceinline__ void phase_norm1024(const void* src_, void* wb_, const bf16_t* ybuf, const float* gain, bf16_t* dst, float* fout) {
    const int tid_ = ftid(), lane = tid_ & 63, wv = tid_ >> 6;
    f32x4 g[4];
#pragma unroll
    for (int i = 0; i < 4; ++i) g[i] = *(const f32x4*)(gain + lane * 4 + 256 * i);
    for (int row = blockIdx.x * 8 + wv; row < NTOK; row += gridDim.x * 8) {
        f32x4 v[4]; float ss = 0.f;
        if (SRC_BF) {
            const bf16_t* s = (const bf16_t*)src_ + (size_t)row * 1024;
#pragma unroll
            for (int i = 0; i < 4; ++i) { const u32x2 r = *(const u32x2*)(s + lane * 4 + 256 * i); v[i][0] = bf_lo(r[0]); v[i][1] = bf_hi(r[0]); v[i][2] = bf_lo(r[1]); v[i][3] = bf_hi(r[1]); }
        } else {
            const float* s = (const float*)src_ + (size_t)row * 1024;
#pragma unroll
            for (int i = 0; i < 4; ++i) v[i] = *(const f32x4*)(s + lane * 4 + 256 * i);
        }
        if (ADD_Y) {
#pragma unroll
            for (int i = 0; i < 4; ++i) {
                const u32x2 a = *(const u32x2*)(ybuf + (size_t)(2 * row) * 1024 + lane * 4 + 256 * i);
                const u32x2 b = *(const u32x2*)(ybuf + (size_t)(2 * row + 1) * 1024 + lane * 4 + 256 * i);
                v[i][0] += bf_lo(a[0]) + bf_lo(b[0]); v[i][1] += bf_hi(a[0]) + bf_hi(b[0]);
                v[i][2] += bf_lo(a[1]) + bf_lo(b[1]); v[i][3] += bf_hi(a[1]) + bf_hi(b[1]);
            }
            if (!FINAL) {
#pragma unroll
                for (int i = 0; i < 4; ++i) {
                    if (SRC_BF) { u32x2 w = {cvt_pk(v[i][0], v[i][1]), cvt_pk(v[i][2], v[i][3])}; *(u32x2*)((bf16_t*)wb_ + (size_t)row * 1024 + lane * 4 + 256 * i) = w;
                        if (RSTD_ONLY) { v[i][0] = bf_lo(w[0]); v[i][1] = bf_hi(w[0]); v[i][2] = bf_lo(w[1]); v[i][3] = bf_hi(w[1]); } }
                    else *(f32x4*)((float*)wb_ + (size_t)row * 1024 + lane * 4 + 256 * i) = v[i];
                }
            }
        }
#pragma unroll
        for (int i = 0; i < 4; ++i) ss += v[i][0] * v[i][0] + v[i][1] * v[i][1] + v[i][2] * v[i][2] + v[i][3] * v[i][3];
        ss = wave_sum(ss);
        const float rstd = rsqrtf(ss * (1.0f / 1024.0f) + EPSF);
        if (RSTD_ONLY) { if (lane == 0) fout[row] = rstd; continue; }
#pragma unroll
        for (int i = 0; i < 4; ++i) {
            const f32x4 o = v[i] * rstd * g[i];
            if (FINAL) *(f32x4*)(fout + (size_t)row * 1024 + lane * 4 + 256 * i) = o;
            else { u32x2 w = {cvt_pk(o[0], o[1]), cvt_pk(o[2], o[3])}; *(u32x2*)(dst + (size_t)row * 1024 + lane * 4 + 256 * i) = w; }
        }
    }
}

__device__ __forceinline__ void phase_mla_post(KArgP p) {
    const bf16_t* tmp = (const bf16_t*)(p->ws + OFF_BIG + BIG_TMP); const float* rstd2 = (const float*)(p->ws + OFF_RSTD);
    bf16_t* cqn = (bf16_t*)(p->ws + OFF_HB); bf16_t* kcat = (bf16_t*)(p->ws + OFF_BIG + BIG_KCAT);
    const float2* cs = (const float2*)(p->ws + OFF_CS);
    const int tid_ = ftid(), lane = tid_ & 63, wv = tid_ >> 6;
    const f32x4 gq = *(const f32x4*)(p->mla_q_norm + lane * 4);
    const float2 gk = *(const float2*)(p->mla_kv_norm + lane * 2);
    for (int g = blockIdx.x * 8 + wv; g < NTOK / 4; g += gridDim.x * 8) {
        u32x2 qr[4]; unsigned kvr[4]; float r2[4]; bf16_t krr[4]; float2 c[4];
#pragma unroll
        for (int j = 0; j < 4; ++j) {
            const int row = 4 * g + j;
            const bf16_t* s = tmp + (size_t)row * 448;
            qr[j] = *(const u32x2*)(s + lane * 4); kvr[j] = *(const unsigned*)(s + 256 + lane * 2); r2[j] = rstd2[row]; krr[j] = s[384 + lane];
            c[j] = cs[(size_t)row * 32 + (lane & 31)];
        }
#pragma unroll
        for (int j = 0; j < 4; ++j) {
            const int row = 4 * g + j;
            const f32x4 q = (f32x4){bf_lo(qr[j][0]), bf_hi(qr[j][0]), bf_lo(qr[j][1]), bf_hi(qr[j][1])} * r2[j];
            const float2 kv = make_float2(bf_lo(kvr[j]) * r2[j], bf_hi(kvr[j]) * r2[j]);
            const float kr = bf2f(krr[j]) * r2[j];
            const float ssq = wave_sum(q[0] * q[0] + q[1] * q[1] + q[2] * q[2] + q[3] * q[3]);
            const float ssk = wave_sum(kv.x * kv.x + kv.y * kv.y);
            const float rq = rsqrtf(ssq * (1.0f / 256.0f) + EPSF), rk = rsqrtf(ssk * (1.0f / 128.0f) + EPSF);
            u32x2 w = {cvt_pk(q[0] * rq * gq[0], q[1] * rq * gq[1]), cvt_pk(q[2] * rq * gq[2], q[3] * rq * gq[3])};
            *(u32x2*)(cqn + (size_t)row * 256 + lane * 4) = w;
            *(unsigned*)(kcat + (size_t)row * 192 + lane * 2) = cvt_pk(kv.x * rk * gk.x, kv.y * rk * gk.y);
            const float other = __shfl_xor(kr, 32);
            const float o = (lane < 32) ? (kr * c[j].x - other * c[j].y) : (kr * c[j].x + other * c[j].y);
            kcat[(size_t)row * 192 + 128 + lane] = (bf16_t)(cvt_pk(o, 0.f) & 0xffffu);
        }
    }
}

template <int N> struct Ptrs { const bf16_t* p[N]; };
template <int WM, int WN, bool A_LDS>
__device__ __forceinline__ void gemm_core(f32x4 (&acc)[4][4], const Ptrs<WM>& ap, const Ptrs<WN>& bp, int nk, char* stage, const char* aL, int ldaLb) {
    static_assert(!A_LDS && WM == 4 && WN == 2, "router shape only");
    (void)aL; (void)ldaLb; (void)nk;
    constexpr int BM = 64 * WM;
    const int tid = ftid(), lane = tid & 63, wid = tid >> 6;
    const int wm = wid / WN, wn = wid % WN, fr = lane & 15, fq = lane >> 4;
    char* sA = stage; char* sB = stage + BM * 144;
    const int soff = (tid >> 3) * 144 + (tid & 7) * 16;
    u32x4 a0[4], b0[2], a1[4], b1[2], a2[4], b2[2];
#define GC_LOAD(RA, RB, kt) { _Pragma("unroll") for (int i = 0; i < 4; ++i) RA[i] = *(const u32x4*)((const char*)ap.p[i] + (size_t)(kt) * 128); \
                              _Pragma("unroll") for (int i = 0; i < 2; ++i) RB[i] = *(const u32x4*)((const char*)bp.p[i] + (size_t)(kt) * 128); }
#define GC_STORE(RA, RB) { _Pragma("unroll") for (int i = 0; i < 4; ++i) *(u32x4*)(sA + soff + i * 9216) = RA[i]; \
                           _Pragma("unroll") for (int i = 0; i < 2; ++i) *(u32x4*)(sB + soff + i * 9216) = RB[i]; }
    const char* aBase = sA + (wm * 64 + fr) * 144 + fq * 16;
    const char* bBase = sB + (wn * 64 + fr) * 144 + fq * 16;
#define GC_MMA() { _Pragma("unroll") for (int ks = 0; ks < 2; ++ks) { bf16x8 af[4], bfr[4]; \
        _Pragma("unroll") for (int m = 0; m < 4; ++m) af[m] = *(const bf16x8*)(aBase + m * 16 * 144 + ks * 64); \
        _Pragma("unroll") for (int n = 0; n < 4; ++n) bfr[n] = *(const bf16x8*)(bBase + n * 16 * 144 + ks * 64); \
        _Pragma("unroll") for (int m = 0; m < 4; ++m) _Pragma("unroll") for (int n = 0; n < 4; ++n) acc[m][n] = mfma16(bfr[n], af[m], acc[m][n]); } }
#define GC_STEP(RA0, RB0, RA1, RB1, kt) { GC_MMA() __syncthreads(); if ((kt) + 1 < 16) GC_STORE(RA1, RB1) if ((kt) + 3 < 16) GC_LOAD(RA0, RB0, (kt) + 3) __syncthreads(); }
    GC_LOAD(a0, b0, 0) GC_LOAD(a1, b1, 1) GC_LOAD(a2, b2, 2)
    GC_STORE(a0, b0)
    __syncthreads();
    GC_STEP(a0, b0, a1, b1, 0) GC_STEP(a1, b1, a2, b2, 1) GC_STEP(a2, b2, a0, b0, 2)
    GC_STEP(a0, b0, a1, b1, 3) GC_STEP(a1, b1, a2, b2, 4) GC_STEP(a2, b2, a0, b0, 5)
    GC_STEP(a0, b0, a1, b1, 6) GC_STEP(a1, b1, a2, b2, 7) GC_STEP(a2, b2, a0, b0, 8)
    GC_STEP(a0, b0, a1, b1, 9) GC_STEP(a1, b1, a2, b2, 10) GC_STEP(a2, b2, a0, b0, 11)
    GC_STEP(a0, b0, a1, b1, 12) GC_STEP(a1, b1, a2, b2, 13) GC_STEP(a2, b2, a0, b0, 14)
    GC_STEP(a0, b0, a1, b1, 15)
#undef GC_LOAD
#undef GC_STORE
#undef GC_MMA
#undef GC_STEP
}
__device__ __forceinline__ void acc_zero(f32x4 (&acc)[4][4]) {
#pragma unroll
    for (int m = 0; m < 4; ++m)
#pragma unroll
        for (int n = 0; n < 4; ++n) acc[m][n] = (f32x4){0.f, 0.f, 0.f, 0.f};
}
namespace pg8 {
constexpr int BM = 256, BK = 64, HALF = 128, HTB = HALF * BK * 2, STAGE_BYTES = 8 * HTB;
__device__ __forceinline__ int lds_byte(int r, int c) { const int st = (r >> 4) * 2 + (c >> 5), rr = r & 15, cc = c & 31, ob = rr * 64 + cc * 2; return st * 1024 + (ob ^ (((ob >> 9) & 1) << 5)); }
__device__ __forceinline__ void stage_rc(int b, int& R, int& C) { const int st = b / 1024, sb = b % 1024, swz = sb ^ (((sb >> 9) & 1) << 5); R = (st >> 1) * 16 + swz / 64; C = (st & 1) * 32 + (swz % 64) / 2; }
struct Unit { int pm, pn, aux; };
__device__ __forceinline__ int perm32(int rho) { const int n = rho >> 4, i = rho & 15; return 8 * (i >> 2) + 4 * n + (i & 3); }
template <class E_> struct is_perm { template <class T> static char t(decltype(&T::PERM)); template <class T> static long t(...); static constexpr bool v = sizeof(t<E_>(0)) == 1; };
template <class E_> struct has_pre { template <class T> static char t(decltype(&T::pre)); template <class T> static long t(...); static constexpr bool v = sizeof(t<E_>(0)) == 1; };
template <class Prob, class Epi>
__device__ __forceinline__ void gemm_phase(lchar* lds, const Prob& P, const Epi& E) {
    const int tid = ftid(), wid = __builtin_amdgcn_readfirstlane(tid >> 6), lane = tid & 63, wr = wid >> 2, wc = wid & 3, fr = lane & 15, fq = lane >> 4;
    const int K = P.K, nt = K / BK;
    int R0, C0, R1, C1; stage_rc(tid * 16, R0, C0); stage_rc(tid * 16 + 8192, R1, C1);
    unsigned voffB[2];
    if constexpr (is_perm<Epi>::v) { voffB[0] = (unsigned)(((R0 & ~31) + perm32(R0 & 31)) * K + C0) * 2u; voffB[1] = (unsigned)(((R1 & ~31) + perm32(R1 & 31)) * K + C1) * 2u; }
    else { voffB[0] = (unsigned)(R0 * K + C0) * 2u; voffB[1] = (unsigned)(R1 * K + C1) * 2u; }
    const size_t hstepB = (size_t)HALF * K * 2;
    const unsigned ldsw = (unsigned)wid * 1024u;
    const int aoff = lds_byte(wr * 64 + fr, fq * 8), boff = lds_byte(wc * 32 + fr, fq * 8);
    const char* Ab = P.A;
#define PG8_SA(b, h) (((b) * 2 + (h)) * HTB)
#define PG8_SB(b, h) ((4 + (b) * 2 + (h)) * HTB)
#define PG8_STAGE_B(bufoff, gbase) do { _Pragma("unroll") for (int _i = 0; _i < 2; ++_i) \
        __builtin_amdgcn_global_load_lds((const unsigned*)((const char*)(gbase) + voffB[_i]), (LAS unsigned*)(lds + (bufoff) + ldsw + _i * 8192), 16, 0, 0); } while (0)
#define PG8_STAGE_A(bufoff, kb, VO, h) do { _Pragma("unroll") for (int _i = 0; _i < 2; ++_i) \
        __builtin_amdgcn_global_load_lds((const unsigned*)(Ab + (kb) + (VO)[h][_i]), (LAS unsigned*)(lds + (bufoff) + ldsw + _i * 8192), 16, 0, 0); } while (0)
#define PG8_LDA(dst, b, h) do { _Pragma("unroll") for (int m = 0; m < 4; ++m) _Pragma("unroll") for (int k = 0; k < 2; ++k) dst[m][k] = *(const LAS bf16x8*)(lds + PG8_SA(b, h) + aoff + m * 2048 + k * 1024); } while (0)
#define PG8_LDB(dst, b, h) do { _Pragma("unroll") for (int n = 0; n < 2; ++n) _Pragma("unroll") for (int k = 0; k < 2; ++k) dst[n][k] = *(const LAS bf16x8*)(lds + PG8_SB(b, h) + boff + n * 2048 + k * 1024); } while (0)
#define PG8_MMA(ai, bj, At, Bt) do { __builtin_amdgcn_s_setprio(1); _Pragma("unroll") for (int m = 0; m < 4; ++m) _Pragma("unroll") for (int n = 0; n < 2; ++n) _Pragma("unroll") for (int k = 0; k < 2; ++k) \
        acc[ai][bj][m][n] = __builtin_amdgcn_mfma_f32_16x16x32_bf16(Bt[n][k], At[m][k], acc[ai][bj][m][n], 0, 0, 0); __builtin_amdgcn_s_setprio(0); } while (0)
#define PG8_WAIT_V(n) asm volatile("s_waitcnt vmcnt(" #n ")" ::: "memory")
#define PG8_WAIT_L(n) asm volatile("s_waitcnt lgkmcnt(" #n ")" ::: "memory")
#define PG8_BAR __builtin_amdgcn_s_barrier()
#define PG8_SCHED __builtin_amdgcn_sched_barrier(0)
    Unit cur, nxt; int ui = 0;
    if (!P.next(0, cur)) return;
    f32x4 acc[2][2][4][2];
#pragma unroll
    for (int a = 0; a < 2; ++a)
#pragma unroll
        for (int b = 0; b < 2; ++b)
#pragma unroll
            for (int m = 0; m < 4; ++m)
#pragma unroll
                for (int n = 0; n < 2; ++n) acc[a][b][m][n] = (f32x4){0.f, 0.f, 0.f, 0.f};
    bf16x8 At[4][2], B0[2][2], B1[2][2];
    unsigned vc[2][2], vn[2][2];
    P.a_off(cur, R0, C0, R1, C1, vc);
    const char* cB = P.b_base(cur);
    if constexpr (has_pre<Epi>::v) E.pre(cur, 0, lds, wid, lane);
    PG8_STAGE_B(PG8_SB(0, 0), cB); PG8_STAGE_B(PG8_SB(0, 1), cB + hstepB); PG8_STAGE_A(PG8_SA(0, 0), (size_t)0, vc, 0); PG8_STAGE_A(PG8_SA(0, 1), (size_t)0, vc, 1);
    if (wr == 1) PG8_BAR;
    PG8_WAIT_V(2); PG8_BAR;
    PG8_STAGE_B(PG8_SB(1, 0), cB + 128); PG8_STAGE_A(PG8_SA(1, 0), (size_t)128, vc, 0); PG8_STAGE_B(PG8_SB(1, 1), cB + hstepB + 128);
    PG8_WAIT_V(6); PG8_BAR;
    for (;;) {
        const bool has_next = P.next(ui + 1, nxt);
        if (has_next) { P.a_off(nxt, R0, C0, R1, C1, vn); if constexpr (has_pre<Epi>::v) E.pre(nxt, (ui + 1) & 3, lds, wid, lane); }
        else { vn[0][0] = vc[0][0]; vn[0][1] = vc[0][1]; vn[1][0] = vc[1][0]; vn[1][1] = vc[1][1]; }
        const char* nB = has_next ? P.b_base(nxt) : cB;
        for (int t = 0; t < nt; t += 2) {
            const bool last = (t == nt - 2);
            const size_t k1 = (size_t)(t + 1) * 128;
            const size_t k2 = last ? (size_t)0 : (size_t)(t + 2) * 128, k3 = k2 + 128;
            const char* b2 = last ? nB : cB + (size_t)(t + 2) * 128; const char* b3 = b2 + 128;
            unsigned s2[2][2];
            s2[0][0] = last ? vn[0][0] : vc[0][0]; s2[0][1] = last ? vn[0][1] : vc[0][1]; s2[1][0] = last ? vn[1][0] : vc[1][0]; s2[1][1] = last ? vn[1][1] : vc[1][1];
            PG8_LDB(B0, 0, 0); PG8_LDB(B1, 0, 1); PG8_SCHED; PG8_LDA(At, 0, 0); PG8_STAGE_A(PG8_SA(1, 1), k1, vc, 1);
            PG8_WAIT_V(8); PG8_WAIT_L(0); PG8_BAR; PG8_MMA(0, 0, At, B0); PG8_MMA(0, 1, At, B1); PG8_BAR; PG8_SCHED;
            PG8_LDA(At, 0, 1); PG8_STAGE_B(PG8_SB(0, 0), b2); PG8_STAGE_B(PG8_SB(0, 1), b2 + hstepB); PG8_STAGE_A(PG8_SA(0, 0), k2, s2, 0);
            PG8_WAIT_V(8); PG8_WAIT_L(0); PG8_BAR; PG8_MMA(1, 0, At, B0); PG8_MMA(1, 1, At, B1); PG8_BAR; PG8_SCHED;
            PG8_LDB(B0, 1, 0); PG8_LDB(B1, 1, 1); PG8_SCHED; PG8_LDA(At, 1, 0); PG8_STAGE_A(PG8_SA(0, 1), k2, s2, 1);
            PG8_WAIT_V(8); PG8_WAIT_L(0); PG8_BAR; PG8_MMA(0, 0, At, B0); PG8_MMA(0, 1, At, B1); PG8_BAR; PG8_SCHED;
            PG8_LDA(At, 1, 1); PG8_STAGE_B(PG8_SB(1, 0), b3); PG8_STAGE_B(PG8_SB(1, 1), b3 + hstepB); PG8_STAGE_A(PG8_SA(1, 0), k3, s2, 0);
            PG8_WAIT_V(8); PG8_WAIT_L(0); PG8_BAR; PG8_MMA(1, 0, At, B0); PG8_MMA(1, 1, At, B1); PG8_BAR; PG8_SCHED;
        }
        if (wr == 0) PG8_BAR;
        if constexpr (has_pre<Epi>::v) E.run(acc, cur, wr, wc, fr, fq, lds, ui & 3); else E(acc, cur, wr, wc, fr, fq);
        if (!has_next) break;
#pragma unroll
        for (int a = 0; a < 2; ++a)
#pragma unroll
            for (int b = 0; b < 2; ++b)
#pragma unroll
                for (int m = 0; m < 4; ++m)
#pragma unroll
                    for (int n = 0; n < 2; ++n) acc[a][b][m][n] = (f32x4){0.f, 0.f, 0.f, 0.f};
        cur = nxt; cB = nB; vc[0][0] = vn[0][0]; vc[0][1] = vn[0][1]; vc[1][0] = vn[1][0]; vc[1][1] = vn[1][1]; ++ui;
        if (wr == 1) PG8_BAR;
    }
    PG8_WAIT_V(0);
    PG8_BAR;
#undef PG8_SA
#undef PG8_SB
#undef PG8_STAGE_A
#undef PG8_STAGE_B
#undef PG8_LDA
#undef PG8_LDB
#undef PG8_MMA
#undef PG8_WAIT_V
#undef PG8_WAIT_L
#undef PG8_BAR
#undef PG8_SCHED
}
struct DenseProb {
    const char* A; const char* Bt; int K, nM, nN, nwg, G, c;
    __device__ __forceinline__ void init(const void* A_, const void* Bt_, int M, int N, int K_) { A = (const char*)A_; Bt = (const char*)Bt_; K = K_; nM = M / BM; nN = N / BM; nwg = nM * nN; G = (int)gridDim.x; c = (int)blockIdx.x; }
    __device__ __forceinline__ bool next(int i, Unit& u) const {
        const long L = (long)i * G + c; if (L >= nwg) return false;
        int wgid = (int)L; { const int q = nwg / 8, r = nwg % 8, xcd = wgid % 8, off = wgid / 8; wgid = (xcd < r ? xcd * (q + 1) : r * (q + 1) + (xcd - r) * q) + off; }
        const int nig = 8 * nN, gid = wgid / nig, fm = gid * 8, gsz = (nM - fm) < 8 ? (nM - fm) : 8;
        u.pm = fm + ((wgid % nig) % gsz); u.pn = (wgid % nig) / gsz; u.aux = 0; return true;
    }
    __device__ __forceinline__ void a_off(const Unit& u, int R0, int C0, int R1, int C1, unsigned (&v)[2][2]) const {
#pragma unroll
        for (int h = 0; h < 2; ++h) { v[h][0] = (unsigned)((u.pm * BM + HALF * h + R0) * K + C0) * 2u; v[h][1] = (unsigned)((u.pm * BM + HALF * h + R1) * K + C1) * 2u; }
    }
    __device__ __forceinline__ const char* b_base(const Unit& u) const { return Bt + (size_t)u.pn * BM * K * 2; }
};
}

#define PG8_EPI_LOOP(...) _Pragma("unroll") for (int ai = 0; ai < 2; ++ai) _Pragma("unroll") for (int m = 0; m < 4; ++m) { const int row = u.pm * 256 + ai * 128 + wr * 64 + m * 16 + fr; \
        _Pragma("unroll") for (int bj = 0; bj < 2; ++bj) _Pragma("unroll") for (int n = 0; n < 2; ++n) { const int col = u.pn * 256 + bj * 128 + wc * 32 + n * 16 + fq * 4; const f32x4 v = acc[ai][bj][m][n]; __VA_ARGS__ } }
struct EpiBf16Out {
    static constexpr bool PERM = true;
    bf16_t* dst; int ld;
    __device__ __forceinline__ void operator()(const f32x4 (&acc)[2][2][4][2], const pg8::Unit& u, int wr, int wc, int fr, int fq) const {
#pragma unroll
        for (int ai = 0; ai < 2; ++ai)
#pragma unroll
            for (int m = 0; m < 4; ++m) {
                bf16_t* rowp = dst + (size_t)(u.pm * 256 + ai * 128 + wr * 64 + m * 16 + fr) * ld + u.pn * 256 + wc * 32 + 8 * fq;
#pragma unroll
                for (int bj = 0; bj < 2; ++bj) {
                    const f32x4 v0 = acc[ai][bj][m][0], v1 = acc[ai][bj][m][1];
                    u32x4 w = {cvt_pk(v0[0], v0[1]), cvt_pk(v0[2], v0[3]), cvt_pk(v1[0], v1[1]), cvt_pk(v1[2], v1[3])};
                    *(u32x4*)(rowp + bj * 128) = w;
                }
            }
    }
};
struct EpiResid {
    const float* base; float* dst;
    __device__ __forceinline__ void operator()(const f32x4 (&acc)[2][2][4][2], const pg8::Unit& u, int wr, int wc, int fr, int fq) const {
#pragma unroll
        for (int ai = 0; ai < 2; ++ai)
#pragma unroll
            for (int mh = 0; mh < 2; ++mh) {
                f32x4 bs[2][2][2];
#pragma unroll
                for (int mm = 0; mm < 2; ++mm)
#pragma unroll
                    for (int bj = 0; bj < 2; ++bj)
#pragma unroll
                        for (int n = 0; n < 2; ++n) bs[mm][bj][n] = *(const f32x4*)(base + (size_t)(u.pm * 256 + ai * 128 + wr * 64 + (2 * mh + mm) * 16 + fr) * 1024 + u.pn * 256 + bj * 128 + wc * 32 + n * 16 + fq * 4);
#pragma unroll
                for (int mm = 0; mm < 2; ++mm)
#pragma unroll
                    for (int bj = 0; bj < 2; ++bj)
#pragma unroll
                        for (int n = 0; n < 2; ++n) *(f32x4*)(dst + (size_t)(u.pm * 256 + ai * 128 + wr * 64 + (2 * mh + mm) * 16 + fr) * 1024 + u.pn * 256 + bj * 128 + wc * 32 + n * 16 + fq * 4) = bs[mm][bj][n] + acc[ai][bj][2 * mh + mm][n];
            }
    }
};
template <bool BASE_BF> struct EpiResidX {
    const void* base; bf16_t* xb; float* part;
    __device__ __forceinline__ void operator()(const f32x4 (&acc)[2][2][4][2], const pg8::Unit& u, int wr, int wc, int fr, int fq) const {
#pragma unroll
        for (int ai = 0; ai < 2; ++ai) {
            f32x4 bs[4][2][2];
#pragma unroll
            for (int m = 0; m < 4; ++m)
#pragma unroll
                for (int bj = 0; bj < 2; ++bj)
#pragma unroll
                    for (int n = 0; n < 2; ++n) {
                        const size_t o = (size_t)(u.pm * 256 + ai * 128 + wr * 64 + m * 16 + fr) * 1024 + u.pn * 256 + bj * 128 + wc * 32 + n * 16 + fq * 4;
                        if (BASE_BF) { const u32x2 r = *(const u32x2*)((const bf16_t*)base + o); bs[m][bj][n] = (f32x4){bf_lo(r[0]), bf_hi(r[0]), bf_lo(r[1]), bf_hi(r[1])}; }
                        else bs[m][bj][n] = *(const f32x4*)((const float*)base + o);
                    }
#pragma unroll
            for (int m = 0; m < 4; ++m) {
                const int row = u.pm * 256 + ai * 128 + wr * 64 + m * 16 + fr;
                float ss = 0.f;
#pragma unroll
                for (int bj = 0; bj < 2; ++bj)
#pragma unroll
                    for (int n = 0; n < 2; ++n) {
                        const f32x4 v = bs[m][bj][n] + acc[ai][bj][m][n];
                        const size_t o = (size_t)row * 1024 + u.pn * 256 + bj * 128 + wc * 32 + n * 16 + fq * 4;
                        u32x2 w = {cvt_pk(v[0], v[1]), cvt_pk(v[2], v[3])}; *(u32x2*)(xb + o) = w;
                        const float r0 = bf_lo(w[0]), r1 = bf_hi(w[0]), r2 = bf_lo(w[1]), r3 = bf_hi(w[1]);
                        ss += r0 * r0 + r1 * r1 + r2 * r2 + r3 * r3;
                    }
                ss += __shfl_xor(ss, 16); ss += __shfl_xor(ss, 32);
                if (fq == 0) part[(size_t)row * 16 + u.pn * 4 + wc] = ss;
            }
        }
    }
};
#define EPIY_TAB (pg8::STAGE_BYTES + 1024)
struct EpiMlaFused {
    bf16_t* cqn; bf16_t* kcat; const float* rstd2; const float2* cs; const float* gq; const float* gk;
    __device__ __forceinline__ void pre(const pg8::Unit&, int, lchar*, int, int) const {}
    __device__ __forceinline__ void run(const f32x4 (&acc)[2][2][4][2], const pg8::Unit& u, int wr, int wc, int fr, int fq, lchar* lds, int) const {
        LAS float* part = (LAS float*)(lds + EPIY_TAB);
        float r2[2][4];
#pragma unroll
        for (int ai = 0; ai < 2; ++ai)
#pragma unroll
            for (int m = 0; m < 4; ++m) r2[ai][m] = rstd2[u.pm * 256 + ai * 128 + wr * 64 + m * 16 + fr];
        const int nbj = u.pn == 0 ? 2 : 1;
#pragma unroll
        for (int ai = 0; ai < 2; ++ai)
#pragma unroll
            for (int m = 0; m < 4; ++m) {
                float s = 0.f;
#pragma unroll
                for (int bj = 0; bj < 2; ++bj)
#pragma unroll
                    for (int n = 0; n < 2; ++n) { const f32x4 v = acc[ai][bj][m][n] * r2[ai][m]; const float q = v[0] * v[0] + v[1] * v[1] + v[2] * v[2] + v[3] * v[3]; s += (bj < nbj) ? q : 0.f; }
                s += __shfl_xor(s, 16); s += __shfl_xor(s, 32);
                if (fq == 0) part[(ai * 128 + wr * 64 + m * 16 + fr) * 4 + wc] = s;
            }
        asm volatile("s_waitcnt lgkmcnt(0)" ::: "memory");
        __builtin_amdgcn_s_barrier();
        asm volatile("" ::: "memory");
        float rn[2][4];
#pragma unroll
        for (int ai = 0; ai < 2; ++ai)
#pragma unroll
            for (int m = 0; m < 4; ++m) {
                const f32x4 pp = *(const LAS f32x4*)(part + (ai * 128 + wr * 64 + m * 16 + fr) * 4);
                const float tot = (pp[0] + pp[1]) + (pp[2] + pp[3]);
                rn[ai][m] = rsqrtf(tot * (u.pn == 0 ? (1.0f / 256.0f) : (1.0f / 128.0f)) + EPSF) * r2[ai][m];
            }
        if (u.pn == 0) {
            f32x4 g[2][2];
#pragma unroll
            for (int bj = 0; bj < 2; ++bj)
#pragma unroll
                for (int n = 0; n < 2; ++n) g[bj][n] = *(const f32x4*)(gq + bj * 128 + wc * 32 + n * 16 + fq * 4);
#pragma unroll
            for (int ai = 0; ai < 2; ++ai)
#pragma unroll
                for (int m = 0; m < 4; ++m) {
                    bf16_t* rowp = cqn + (size_t)(u.pm * 256 + ai * 128 + wr * 64 + m * 16 + fr) * 256 + wc * 32 + fq * 4;
#pragma unroll
                    for (int bj = 0; bj < 2; ++bj)
#pragma unroll
                        for (int n = 0; n < 2; ++n) { const f32x4 o = acc[ai][bj][m][n] * rn[ai][m] * g[bj][n]; u32x2 w = {cvt_pk(o[0], o[1]), cvt_pk(o[2], o[3])}; *(u32x2*)(rowp + bj * 128 + n * 16) = w; }
                }
        } else {
            f32x4 g[2];
#pragma unroll
            for (int n = 0; n < 2; ++n) g[n] = *(const f32x4*)(gk + wc * 32 + n * 16 + fq * 4);
            const int j0 = wc * 16 + fq * 4;
#pragma unroll
            for (int ai = 0; ai < 2; ++ai) {
                f32x4 cA[4], cB[4];
#pragma unroll
                for (int m = 0; m < 4; ++m) {
                    const f32x4* cp = (const f32x4*)(cs + (size_t)(u.pm * 256 + ai * 128 + wr * 64 + m * 16 + fr) * 32 + (wc < 2 ? j0 : 0)); cA[m] = cp[0]; cB[m] = cp[1];
                }
#pragma unroll
                for (int m = 0; m < 4; ++m) {
                    const size_t row = (size_t)(u.pm * 256 + ai * 128 + wr * 64 + m * 16 + fr);
#pragma unroll
                    for (int n = 0; n < 2; ++n) { const f32x4 o = acc[ai][0][m][n] * rn[ai][m] * g[n]; u32x2 w = {cvt_pk(o[0], o[1]), cvt_pk(o[2], o[3])}; *(u32x2*)(kcat + row * 192 + wc * 32 + n * 16 + fq * 4) = w; }
                    if (wc < 2) {
                        const f32x4 t1 = acc[ai][1][m][0] * r2[ai][m], t2 = acc[ai][1][m][1] * r2[ai][m];
                        const float cx[4] = {cA[m][0], cA[m][2], cB[m][0], cB[m][2]}, cy[4] = {cA[m][1], cA[m][3], cB[m][1], cB[m][3]};
                        f32x4 o1, o2;
#pragma unroll
                        for (int e = 0; e < 4; ++e) { o1[e] = t1[e] * cx[e] - t2[e] * cy[e]; o2[e] = t2[e] * cx[e] + t1[e] * cy[e]; }
                        u32x2 w1 = {cvt_pk(o1[0], o1[1]), cvt_pk(o1[2], o1[3])}, w2 = {cvt_pk(o2[0], o2[1]), cvt_pk(o2[2], o2[3])};
                        *(u32x2*)(kcat + row * 192 + 128 + j0) = w1; *(u32x2*)(kcat + row * 192 + 160 + j0) = w2;
                    }
                }
            }
        }
    }
};
struct EpiMlaIn {
    bf16_t* tmp;
    __device__ __forceinline__ void operator()(const f32x4 (&acc)[2][2][4][2], const pg8::Unit& u, int wr, int wc, int fr, int fq) const {
        PG8_EPI_LOOP({ if (col < 448) { u32x2 w = {cvt_pk(v[0], v[1]), cvt_pk(v[2], v[3])}; *(u32x2*)(tmp + (size_t)row * 448 + col) = w; } })
    }
};
#define QSCALE (0.07216878364870322f * 1.4426950408889634f)
struct EpiQ {
    bf16_t* qcat; const float2* cs;
    __device__ __forceinline__ void operator()(const f32x4 (&acc)[2][2][4][2], const pg8::Unit& u, int wr, int wc, int fr, int fq) const {
        if (u.pn < 4) {
            PG8_EPI_LOOP({ const f32x4 s = v * QSCALE; u32x2 w = {cvt_pk(s[0], s[1]), cvt_pk(s[2], s[3])};
                           *(u32x2*)(qcat + (size_t)row * 1536 + (col >> 7) * 192 + (col & 127)) = w; })
        } else {
            const int jj = 16 * (wc & 1) + 4 * fq;
#pragma unroll
            for (int ai = 0; ai < 2; ++ai) {
                f32x4 cA[4], cB[4];
#pragma unroll
                for (int m = 0; m < 4; ++m) {
                    const int row = u.pm * 256 + ai * 128 + wr * 64 + m * 16 + fr;
                    const f32x4* cp = (const f32x4*)(cs + (size_t)row * 32 + jj); cA[m] = cp[0]; cB[m] = cp[1];
                }
#pragma unroll
                for (int m = 0; m < 4; ++m) {
                    const int row = u.pm * 256 + ai * 128 + wr * 64 + m * 16 + fr;
                    const float cx[4] = {cA[m][0], cA[m][2], cB[m][0], cB[m][2]}, cy[4] = {cA[m][1], cA[m][3], cB[m][1], cB[m][3]};
#pragma unroll
                    for (int bj = 0; bj < 2; ++bj) {
                        const int head = (u.pn - 4) * 4 + 2 * bj + (wc >> 1);
                        const f32x4 t1 = acc[ai][bj][m][0], t2 = acc[ai][bj][m][1];
                        f32x4 o1, o2;
#pragma unroll
                        for (int e = 0; e < 4; ++e) { o1[e] = (t1[e] * cx[e] - t2[e] * cy[e]) * QSCALE; o2[e] = (t2[e] * cx[e] + t1[e] * cy[e]) * QSCALE; }
                        u32x2 w1 = {cvt_pk(o1[0], o1[1]), cvt_pk(o1[2], o1[3])}, w2 = {cvt_pk(o2[0], o2[1]), cvt_pk(o2[2], o2[3])};
                        bf16_t* dst = qcat + (size_t)row * 1536 + head * 192 + 128 + jj;
                        *(u32x2*)dst = w1; *(u32x2*)(dst + 32) = w2;
                    }
                }
            }
        }
    }
};

__device__ __forceinline__ void phase_router(KArgP p, int layer, const bf16_t* A, char* lds) {
    const float* part = (const float*)(p->ws + OFF_ALR); float* RSTD = (float*)(p->ws + OFF_RSTD);
    const bf16_t* Bt = (const bf16_t*)(p->ws + OFF_ROUT) + (size_t)layer * 128 * 1024;
    unsigned* gcnt = (unsigned*)p->ws + CTRL_GCNT + layer * 64;
    int* lists = (int*)(p->ws + OFF_LISTS); float* gates = (float*)(p->ws + OFF_GATES); float* lrstd = (float*)(p->ws + OFF_LRSTD);
    const int tid = ftid(), lane = tid & 63, wid = tid >> 6, wm = wid >> 1, wn = wid & 1, fr = lane & 15, fq = lane >> 4;
    const int srow = tid >> 3, scc = tid & 7;
    float* lg = (float*)lds;
    int* hist = (int*)(lds + 256 * 81 * 4);
    int* hbase = hist + 64;
    for (int u = blockIdx.x; u < NTOK / 256; u += gridDim.x) {
        Ptrs<4> ap; Ptrs<2> bp;
#pragma unroll
        for (int i = 0; i < 4; ++i) ap.p[i] = A + (size_t)(u * 256 + srow + 64 * i) * 1024 + scc * 8;
#pragma unroll
        for (int i = 0; i < 2; ++i) bp.p[i] = Bt + (size_t)(srow + 64 * i) * 1024 + scc * 8;
        f32x4 acc[4][4]; acc_zero(acc);
        gemm_core<4, 2, false>(acc, ap, bp, 16, lds, nullptr, 0);
#pragma unroll
        for (int mb = 0; mb < 4; ++mb)
#pragma unroll
            for (int nb = 0; nb < 4; ++nb) {
                const int m = wm * 64 + mb * 16 + fr, n = wn * 64 + nb * 16 + fq * 4;
                if (n < 80) {
#pragma unroll
                    for (int e = 0; e < 4; ++e) lg[m * 81 + n + e] = acc[mb][nb][e];
                }
            }
        if (tid < 64) hist[tid] = 0;
        __syncthreads();
        int e1 = 0, e2 = 0, lp1 = 0, lp2 = 0; float g1 = 0.f, g2 = 0.f, rstd_t = 0.f;
        if (tid < 256) {
            const float* l = lg + tid * 81;
            float rstd;
            {
                const f32x4* pp = (const f32x4*)(part + (size_t)(u * 256 + tid) * 16);
                const f32x4 a = pp[0], b = pp[1], c = pp[2], d = pp[3];
                const float ssum = ((a[0] + a[1]) + (a[2] + a[3])) + ((b[0] + b[1]) + (b[2] + b[3])) + ((c[0] + c[1]) + (c[2] + c[3])) + ((d[0] + d[1]) + (d[2] + d[3]));
                rstd = rsqrtf(ssum * (1.0f / 1024.0f) + EPSF);
                RSTD[u * 256 + tid] = rstd; rstd_t = rstd;
            }
            float gm = l[0]; int gs = 0;
#pragma unroll
            for (int j = 1; j < 8; ++j) { const float v = l[j]; if (v > gm) { gm = v; gs = j; } }
            float den = 0.f;
#pragma unroll
            for (int j = 0; j < 8; ++j) den += __expf((l[j] - gm) * rstd);
            const float gw = 1.0f / den;
            const float* el = l + 8 + gs * 8;
            float m1 = el[0]; int i1 = 0;
#pragma unroll
            for (int j = 1; j < 8; ++j) { const float v = el[j]; if (v > m1) { m1 = v; i1 = j; } }
            float m2 = -3.0e38f; int i2 = 0;
#pragma unroll
            for (int j = 0; j < 8; ++j) { const float v = el[j]; if (j != i1 && v > m2) { m2 = v; i2 = j; } }
            const float p2 = __expf((m2 - m1) * rstd), inv = 1.0f / (1.0f + p2);
            g1 = gw * inv; g2 = gw * p2 * inv;
            e1 = gs * 8 + i1; e2 = gs * 8 + i2;
            lp1 = atomicAdd(&hist[e1], 1); lp2 = atomicAdd(&hist[e2], 1);
        }
        __syncthreads();
        if (tid < 64) { const int c = hist[tid]; hbase[tid] = c ? (int)atomicAdd(&gcnt[tid], (unsigned)c) : 0; }
        __syncthreads();
        if (tid < 256) {
            const int t = u * 256 + tid;
            lists[(size_t)e1 * 65536 + hbase[e1] + lp1] = 2 * t; lrstd[(size_t)e1 * 65536 + hbase[e1] + lp1] = rstd_t;
            lists[(size_t)e2 * 65536 + hbase[e2] + lp2] = 2 * t + 1; lrstd[(size_t)e2 * 65536 + hbase[e2] + lp2] = rstd_t;
            gates[2 * t] = g1; gates[2 * t + 1] = g2;
        }
        __syncthreads();
    }
}

struct ExpTables { LAS int* pre; LAS int* cnt; LAS int* b2e; };
__device__ __forceinline__ ExpTables expert_tables(KArgP p, int layer, lchar* lds) {
    ExpTables t; t.pre = (LAS int*)(lds + pg8::STAGE_BYTES); t.cnt = t.pre + 72; t.b2e = (LAS int*)(lds + pg8::STAGE_BYTES + 9216);
    const unsigned* gcnt = (const unsigned*)p->ws + CTRL_GCNT + layer * 64;
    __syncthreads();
    const int tx = ftid();
    if (tx < 64) t.cnt[tx] = (int)gcnt[tx];
    __syncthreads();
    if (tx < 64) {
        const int nb = (t.cnt[tx] + 255) >> 8;
        int inc = nb;
#pragma unroll
        for (int o = 1; o < 64; o <<= 1) { const int v = __shfl_up(inc, o); if (tx >= o) inc += v; }
        const int start = inc - nb;
        t.pre[tx] = start; if (tx == 63) t.pre[64] = inc;
        for (int rb = start; rb < inc; ++rb) t.b2e[rb] = tx;
    }
    __syncthreads();
    return t;
}
template <bool GATHER> struct ExpProb {
    const char* A; const char* Bt; int K, nN, nblk, G, c; size_t estride; ExpTables tb; const int* lists;
    __device__ __forceinline__ bool next(int i, pg8::Unit& u) const {
        const int j = c >> 3, R = (G >> 3) / nN * 8;
        const int rb = i * R + (c & 7) + 8 * (j / nN);
        if (j / nN >= (G >> 3) / nN || rb >= nblk) return false;
        u.pm = rb; u.pn = j % nN; u.aux = tb.b2e[rb]; return true;
    }
    __device__ __forceinline__ void a_off(const pg8::Unit& u, int R0, int C0, int R1, int C1, unsigned (&v)[2][2]) const {
        if constexpr (GATHER) {
            const int e = u.aux, j0 = (u.pm - tb.pre[e]) * 256, cn = tb.cnt[e];
#pragma unroll
            for (int h = 0; h < 2; ++h) {
                int i0 = j0 + 128 * h + R0, i1 = j0 + 128 * h + R1; i0 = i0 < cn ? i0 : j0; i1 = i1 < cn ? i1 : j0;
                const int t0 = lists[(size_t)e * 65536 + i0] >> 1, t1 = lists[(size_t)e * 65536 + i1] >> 1;
                v[h][0] = (unsigned)(t0 * 1024 + C0) * 2u; v[h][1] = (unsigned)(t1 * 1024 + C1) * 2u;
            }
        } else {
#pragma unroll
            for (int h = 0; h < 2; ++h) { v[h][0] = (unsigned)((u.pm * 256 + 128 * h + R0) * K + C0) * 2u; v[h][1] = (unsigned)((u.pm * 256 + 128 * h + R1) * K + C1) * 2u; }
        }
    }
    __device__ __forceinline__ const char* b_base(const pg8::Unit& u) const { return Bt + (size_t)u.aux * estride + (size_t)u.pn * 256 * K * 2; }
};
struct EpiHid {
    bf16_t* hid; ExpTables tb; const int* lists; const float* rstd;
    __device__ __forceinline__ void operator()(const f32x4 (&acc)[2][2][4][2], const pg8::Unit& u, int wr, int wc, int fr, int fq) const {
        const int e = u.aux, j0 = (u.pm - tb.pre[e]) * 256, cn = tb.cnt[e];
        float rr[2][4];
#pragma unroll
        for (int ai = 0; ai < 2; ++ai)
#pragma unroll
            for (int m = 0; m < 4; ++m) { const int idx = j0 + ai * 128 + wr * 64 + m * 16 + fr; rr[ai][m] = rstd[(size_t)e * 65536 + (idx < cn ? idx : j0)]; }
#pragma unroll
        for (int ai = 0; ai < 2; ++ai)
#pragma unroll
            for (int m = 0; m < 4; ++m) {
                const int row = u.pm * 256 + ai * 128 + wr * 64 + m * 16 + fr; const float r = rr[ai][m];
#pragma unroll
                for (int bj = 0; bj < 2; ++bj) {
                    const f32x4 a1 = acc[ai][bj][m][0] * r, a3 = acc[ai][bj][m][1] * r;
                    u32x2 w = {cvt_pk(silu_f(a1[0]) * a3[0], silu_f(a1[1]) * a3[1]), cvt_pk(silu_f(a1[2]) * a3[2], silu_f(a1[3]) * a3[3])};
                    *(u32x2*)(hid + (size_t)row * 256 + u.pn * 128 + bj * 64 + wc * 16 + 4 * fq) = w;
                }
            }
    }
};
struct EpiY {
    static constexpr bool PERM = true;
    bf16_t* ybuf; const int* slot_aid; const float* slot_gate;
    __device__ __forceinline__ void pre(const pg8::Unit& u, int par, lchar* lds, int wid, int lane) const {
        if (wid < 2) {
            const char* src = (wid == 0 ? (const char*)slot_aid : (const char*)slot_gate) + (size_t)u.pm * 1024 + lane * 16;
            __builtin_amdgcn_global_load_lds((const unsigned*)src, (LAS unsigned*)(lds + EPIY_TAB + par * 2048 + wid * 1024), 16, 0, 0);
        }
    }
    __device__ __forceinline__ void run(const f32x4 (&acc)[2][2][4][2], const pg8::Unit& u, int wr, int wc, int fr, int fq, lchar* lds, int par) const {
        const lchar* tab = lds + EPIY_TAB + par * 2048 + (wr * 64 + fr) * 4;
#pragma unroll
        for (int ai = 0; ai < 2; ++ai)
#pragma unroll
            for (int m = 0; m < 4; ++m) {
                const int a = ldsr<int>(tab + (ai * 128 + m * 16) * 4); const float g = ldsr<float>(tab + 1024 + (ai * 128 + m * 16) * 4);
                if (a >= 0) {
#pragma unroll
                    for (int bj = 0; bj < 2; ++bj) {
                        const f32x4 v0 = acc[ai][bj][m][0] * g, v1 = acc[ai][bj][m][1] * g;
                        u32x4 w = {cvt_pk(v0[0], v0[1]), cvt_pk(v0[2], v0[3]), cvt_pk(v1[0], v1[1]), cvt_pk(v1[2], v1[3])};
                        *(u32x4*)(ybuf + (size_t)a * 1024 + u.pn * 256 + bj * 128 + wc * 32 + 8 * fq) = w;
                    }
                }
            }
    }
};
#define BIG_HID (256 * MB)
__device__ __forceinline__ void phase_expert1(KArgP p, int layer, const bf16_t* xb, lchar* lds) {
    ExpProb<true> P; P.tb = expert_tables(p, layer, lds);
    P.A = (const char*)xb; P.Bt = p->ws + OFF_MOE13; P.K = 1024; P.nN = 2; P.nblk = P.tb.pre[64]; P.G = (int)gridDim.x; P.c = (int)blockIdx.x; P.estride = (size_t)512 * 1024 * 2;
    P.lists = (const int*)(p->ws + OFF_LISTS);
    {
        int* slot_aid = (int*)(p->ws + OFF_SLOT); float* slot_gate = (float*)(p->ws + OFF_SLOT + MB);
        const float* gates = (const float*)(p->ws + OFF_GATES);
        const int nsl = P.tb.pre[64] * 256;
        for (int sl = blockIdx.x * 512 + ftid(); sl < nsl; sl += gridDim.x * 512) {
            const int rb = sl >> 8, e = P.tb.b2e[rb];
            const int idx = (rb - P.tb.pre[e]) * 256 + (sl & 255);
            int a = -1; float g = 0.f;
            if (idx < P.tb.cnt[e]) { a = P.lists[(size_t)e * 65536 + idx]; g = gates[a]; }
            slot_aid[sl] = a; slot_gate[sl] = g;
        }
    }
    EpiHid E{(bf16_t*)(p->ws + OFF_BIG + BIG_HID), P.tb, P.lists, (const float*)(p->ws + OFF_LRSTD)};
    pg8::gemm_phase(lds, P, E);
}
__device__ __forceinline__ void phase_expert2(KArgP p, int layer, lchar* lds) {
    ExpProb<false> P; P.tb = expert_tables(p, layer, lds);
    P.A = p->ws + OFF_BIG + BIG_HID; P.Bt = p->ws + OFF_MOE2; P.K = 256; P.nN = 4; P.nblk = P.tb.pre[64]; P.G = (int)gridDim.x; P.c = (int)blockIdx.x; P.estride = (size_t)1024 * 256 * 2;
    P.lists = (const int*)(p->ws + OFF_LISTS);
    EpiY E{(bf16_t*)(p->ws + OFF_BIG), (const int*)(p->ws + OFF_SLOT), (const float*)(p->ws + OFF_SLOT + MB)};
    pg8::gemm_phase(lds, P, E);
}

__device__ __forceinline__ float log_sigmoid_f(float z) { return fminf(z, 0.f) - __logf(1.0f + __expf(-fabsf(z))); }
__device__ __forceinline__ void phase_gla_prep(KArgP p, lchar* lds) {
    bf16_t* proj = (bf16_t*)(p->ws + OFF_BIG);
    const bf16_t* HB = (const bf16_t*)(p->ws + OFF_HB);
    const bf16_t* balr = (const bf16_t*)(p->ws + OFF_GLAIN) + (size_t)3072 * 1024;
    float* EG = (float*)(p->ws + OFF_EG); float* EM = (float*)(p->ws + OFF_EM); float* EL = (float*)(p->ws + OFF_EL);
    LAS float* sa = (LAS float*)lds;
    LAS float* sb = (LAS float*)(lds + 4096);
    LAS float* gs = (LAS float*)(lds + 8192);
    const int tid = ftid(), c = tid, lane = tid & 63, w = tid >> 6, fr = lane & 15, fq = lane >> 4;
    float wg[16];
#pragma unroll
    for (int r = 0; r < 16; ++r) wg[r] = p->gla_w_gate[r * 512 + c];
    const float bias = p->gla_b_gate[c];
    for (int u = blockIdx.x; u < NTOK / 64; u += gridDim.x) {
        const int t0 = u * 64;
        __syncthreads();
        {
            f32x4 cacc = {0.f, 0.f, 0.f, 0.f};
            const int wq = w & 3, kh = (w >> 2) * 16;
            const bf16_t* ap = HB + (size_t)(t0 + 16 * wq + fr) * 1024 + fq * 8 + kh * 32; const bf16_t* bp = balr + (size_t)fr * 1024 + fq * 8 + kh * 32;
            bf16x8 af[16], bf_[16];
#pragma unroll
            for (int ks = 0; ks < 16; ++ks) { af[ks] = *(const bf16x8*)(ap + ks * 32); bf_[ks] = *(const bf16x8*)(bp + ks * 32); }
#pragma unroll
            for (int ks = 0; ks < 16; ++ks) cacc = mfma16(bf_[ks], af[ks], cacc);
            *(LAS f32x4*)((w < 4 ? sa : sb) + (16 * wq + fr) * 16 + 4 * fq) = cacc;
        }
        __syncthreads();
        if (tid < 256) *(LAS f32x4*)(sa + tid * 4) = *(LAS f32x4*)(sa + tid * 4) + *(LAS f32x4*)(sb + tid * 4);
        __syncthreads();
        float g = 0.f;
        for (int t = 0; t < 64; ++t) {
            float z = bias;
#pragma unroll
            for (int r = 0; r < 16; ++r) z += sa[t * 16 + r] * wg[r];
            g += log_sigmoid_f(z) * (1.0f / 16.0f);
            gs[t * 512 + c] = g;
        }
        {
            const float gmid = gs[32 * 512 + c];
            EG[(size_t)u * 512 + c] = __expf(g); EM[(size_t)u * 512 + c] = __expf(gmid); EL[(size_t)u * 512 + c] = __expf(g - gmid);
        }
        __syncthreads();
#pragma unroll 1
        for (int i0 = 0; i0 < 16; i0 += 8) {
            u32x4 raw[8];
#pragma unroll
            for (int i = 0; i < 8; ++i) { const int id = tid + 512 * (i0 + i), t = id >> 7, cc = id & 127; raw[i] = *(const u32x4*)(proj + (size_t)(t0 + t) * 3072 + (cc >> 6) * 512 + (cc & 63) * 8); }
#pragma unroll
            for (int i = 0; i < 8; ++i) {
                const int id = tid + 512 * (i0 + i), t = id >> 7, cc = id & 127, which = cc >> 6, ch = (cc & 63) * 8;
                const f32x4 g0 = *(const LAS f32x4*)(gs + t * 512 + ch), g1 = *(const LAS f32x4*)(gs + t * 512 + ch + 4);
                const f32x4 m0 = *(const LAS f32x4*)(gs + 32 * 512 + ch), m1 = *(const LAS f32x4*)(gs + 32 * 512 + ch + 4);
                float f[8];
#pragma unroll
                for (int e = 0; e < 4; ++e) { const float d0 = g0[e] - m0[e], d1 = g1[e] - m1[e]; f[e] = which ? __expf(-d0) : 0.08838834764831845f * __expf(d0); f[4 + e] = which ? __expf(-d1) : 0.08838834764831845f * __expf(d1); }
                u32x4 o;
                o[0] = cvt_pk(bf_lo(raw[i][0]) * f[0], bf_hi(raw[i][0]) * f[1]); o[1] = cvt_pk(bf_lo(raw[i][1]) * f[2], bf_hi(raw[i][1]) * f[3]);
                o[2] = cvt_pk(bf_lo(raw[i][2]) * f[4], bf_hi(raw[i][2]) * f[5]); o[3] = cvt_pk(bf_lo(raw[i][3]) * f[6], bf_hi(raw[i][3]) * f[7]);
                *(u32x4*)(proj + (size_t)(t0 + t) * 3072 + which * 512 + ch) = o;
            }
        }
    }
}

__device__ __forceinline__ void phase_gla_s1(KArgP p, lchar* lds) {
    const bf16_t* proj = (const bf16_t*)(p->ws + OFF_BIG);
    const float* EG = (const float*)(p->ws + OFF_EG); const float* EL = (const float*)(p->ws + OFF_EL);
    float* SLOC = (float*)(p->ws + OFF_SLOC); float* DSEG = (float*)(p->ws + OFF_DSEG);
    lchar* sK = lds; lchar* sV = lds + 17408; lchar* tbl = lds + 17408 + 33792;
    const int tid = ftid(), lane = tid & 63, w = tid >> 6, hh = lane >> 5;
    const int trrow = 8 * hh + ((lane & 15) >> 2), trcol = 16 * ((lane >> 4) & 1) + 4 * (lane & 3);
    const lchar* vtr = opq(sV + trrow * 528 + (32 * w + trcol) * 2);
    const lchar* ktr = opq(sK + trrow * 272 + trcol * 2);
    const lchar* tb = opq(tbl + 16 * hh);
    for (int u = blockIdx.x; u < 256; u += gridDim.x) {
        const int seg = u & 7, bh = u >> 3, b = bh >> 2, h = bh & 3;
        if (seg == 7) continue;
        f32x16 S[4];
#pragma unroll
        for (int i = 0; i < 4; ++i)
#pragma unroll
            for (int r = 0; r < 16; ++r) S[i][r] = 0.f;
        u32x4 pk[2], pv[4]; float ptab = 0.f;
#define S1_LOAD(n_) do { const int cn_ = seg * 16 + (n_), t0_ = b * SEQL + cn_ * 64, uc_ = b * 128 + cn_; \
            _Pragma("unroll") for (int i = 0; i < 2; ++i) { const int id = tid + 512 * i, row = id >> 4, cc = id & 15; pk[i] = *(const u32x4*)(proj + (size_t)(t0_ + row) * 3072 + 512 + h * 128 + cc * 8); } \
            _Pragma("unroll") for (int i = 0; i < 4; ++i) { const int id = tid + 512 * i, row = id >> 5, cc = id & 31; pv[i] = *(const u32x4*)(proj + (size_t)(t0_ + row) * 3072 + 1024 + h * 256 + cc * 8); } \
            if (tid < 128) ptab = EG[(size_t)uc_ * 512 + h * 128 + tid]; else if (tid < 256) ptab = EL[(size_t)uc_ * 512 + h * 128 + tid - 128]; } while (0)
#define S1_STORE() do { \
            _Pragma("unroll") for (int i = 0; i < 2; ++i) { const int id = tid + 512 * i, row = id >> 4, cc = id & 15; ldsw<u32x4>(sK + row * 272 + cc * 16, pk[i]); } \
            _Pragma("unroll") for (int i = 0; i < 4; ++i) { const int id = tid + 512 * i, row = id >> 5, cc = id & 31; ldsw<u32x4>(sV + row * 528 + cc * 16, pv[i]); } \
            if (tid < 256) ldsw<float>(tbl + tid * 4, ptab); } while (0)
        S1_LOAD(0);
        __syncthreads();
        S1_STORE();
#pragma unroll 1
        for (int n = 0; n < 16; ++n) {
            __syncthreads();
            if (n + 1 < 16) S1_LOAD(n + 1);
            bf16x8 vf[4];
#pragma unroll
            for (int ks = 0; ks < 4; ++ks) vf[ks] = cat8(tr16(vtr + 16 * ks * 528), tr16(vtr + (16 * ks + 4) * 528));
#pragma unroll
            for (int mb = 0; mb < 4; ++mb) {
                f32x16 U;
#pragma unroll
                for (int r = 0; r < 16; ++r) U[r] = 0.f;
#pragma unroll
                for (int ks = 0; ks < 4; ++ks) U = mfma32(cat8(tr16(ktr + 16 * ks * 272 + 64 * mb), tr16(ktr + (16 * ks + 4) * 272 + 64 * mb)), vf[ks], U);
#pragma unroll
                for (int rg = 0; rg < 4; ++rg) {
                    const f32x4 eg = ldsr<f32x4>(tb + (32 * mb + 8 * rg) * 4), el = ldsr<f32x4>(tb + 512 + (32 * mb + 8 * rg) * 4);
#pragma unroll
                    for (int e = 0; e < 4; ++e) S[mb][4 * rg + e] = S[mb][4 * rg + e] * eg[e] + el[e] * U[4 * rg + e];
                }
                asm volatile("" : "+v"(S[mb]));
            }
            if (n + 1 < 16) { __syncthreads(); S1_STORE(); }
        }
        {
            float* dst = SLOC + (((size_t)u * 8 + w) * 64 + lane) * 64;
#pragma unroll
            for (int mb = 0; mb < 4; ++mb)
#pragma unroll
                for (int rg = 0; rg < 4; ++rg) { f32x4 v = {S[mb][4 * rg], S[mb][4 * rg + 1], S[mb][4 * rg + 2], S[mb][4 * rg + 3]}; *(f32x4*)(dst + mb * 16 + rg * 4) = v; }
        }
        if (tid < 128) { float pr = 1.f; for (int n = 0; n < 16; ++n) pr *= EG[(size_t)(b * 128 + seg * 16 + n) * 512 + h * 128 + tid]; DSEG[u * 128 + tid] = pr; }
    }
}
#define S3_FETCH(T0, UC) { const int fx_ = ftid(); \
    { const int sel_ = (fx_ >> 7) < 2 ? (fx_ >> 7) : 2;        \
      ptab = *(const float*)((const char*)EG + (size_t)(UC) * 2048 + h * 512 + (unsigned)(sel_ * (int)(2 * MB) + (fx_ & 127) * 4)); } \
    _Pragma("unroll") for (int i = 0; i < 2; ++i) { const int id = fx_ + 512 * i, row = id >> 4, cc = id & 15; \
        const bf16_t* src_ = proj + (size_t)((T0) + row) * 3072 + h * 128 + cc * 8; tq[i] = *(const u32x4*)src_; tk[i] = *(const u32x4*)(src_ + 512); } \
    _Pragma("unroll") for (int i = 0; i < 4; ++i) { const int id = fx_ + 512 * i, row = id >> 5, cc = id & 31; \
        const bf16_t* vsrc_ = proj + (size_t)((T0) + row) * 3072 + 1024 + h * 256 + cc * 8; tv[i] = *(const u32x4*)vsrc_; tr[i] = *(const u32x4*)(vsrc_ + 1024); } }
__device__ __forceinline__ void phase_gla_s3(KArgP p, lchar* lds) {
    const bf16_t* proj = (const bf16_t*)(p->ws + OFF_BIG);
    const float* EG = (const float*)(p->ws + OFF_EG); const float* EM = (const float*)(p->ws + OFF_EM); const float* EL = (const float*)(p->ws + OFF_EL);
    const float* SLOC = (const float*)(p->ws + OFF_SLOC); const float* DSEG = (const float*)(p->ws + OFF_DSEG);
    bf16_t* on = (bf16_t*)(p->ws + OFF_HB);
    lchar* tbl = lds;
    lchar* sQ = lds + 3584; lchar* sK = sQ + 17408; lchar* sV = sK + 17408; lchar* sP = sV + 33792; lchar* sR = sP + 9216;
    const int tid = ftid(), lane = tid & 63, w = tid >> 6, l31 = lane & 31, hh = lane >> 5, fr = lane & 15, fq = lane >> 4;
    const int trrow = 8 * hh + ((lane & 15) >> 2), trcol = 16 * ((lane >> 4) & 1) + 4 * (lane & 3);
    const lchar* vtr = opq(sV + trrow * 528 + (32 * w + trcol) * 2);
    const lchar* ktr = opq(sK + trrow * 272 + trcol * 2);
    const lchar* tb = opq(tbl + 16 * hh);
    const lchar* prd = opq(sP + l31 * 144 + 16 * hh);
    const lchar* qrd = opq(sQ + l31 * 272 + 8 * hh);
    lchar* redw = opq(tbl + 1536 + (w * 64 + l31) * 4);
    const lchar* redr = opq(tbl + 1536 + l31 * 4);
    for (int u = blockIdx.x; u < 256; u += gridDim.x) {
        const int seg = u & 7, bh = u >> 3, b = bh >> 2, h = bh & 3;
        u32x4 tq[2], tk[2], tv[4], tr[4]; float ptab;
        S3_FETCH(b * SEQL + seg * 16 * 64, b * 128 + seg * 16)
        f32x16 S[4];
#pragma unroll
        for (int i = 0; i < 4; ++i)
#pragma unroll
            for (int r = 0; r < 16; ++r) S[i][r] = 0.f;
        for (int sp = 0; sp < seg; ++sp) {
            const int up = bh * 8 + sp;
            __syncthreads();
            if (tid < 128) ldsw<float>(tbl + tid * 4, DSEG[up * 128 + tid]);
            __syncthreads();
            const float* srcp = SLOC + (((size_t)up * 8 + w) * 64 + lane) * 64;
#pragma unroll
            for (int mb = 0; mb < 4; ++mb)
#pragma unroll
                for (int rg = 0; rg < 4; ++rg) {
                    const f32x4 v = *(const f32x4*)(srcp + mb * 16 + rg * 4), dg = ldsr<f32x4>(tb + (32 * mb + 8 * rg) * 4);
#pragma unroll
                    for (int e = 0; e < 4; ++e) S[mb][4 * rg + e] = S[mb][4 * rg + e] * dg[e] + v[e];
                }
        }
        for (int n = 0; n < 16; ++n) {
            const int cn = seg * 16 + n, t0 = b * SEQL + cn * 64, uc = b * 128 + cn;
            __syncthreads();
            {
                const int ft = ftid();
#pragma unroll
                for (int i = 0; i < 2; ++i) { const int id = ft + 512 * i, row = id >> 4, cc = id & 15;
                    ldsw<u32x4>(sQ + row * 272 + cc * 16, tq[i]); ldsw<u32x4>(sK + row * 272 + cc * 16, tk[i]); }
#pragma unroll
                for (int i = 0; i < 4; ++i) { const int id = ft + 512 * i, row = id >> 5, cc = id & 31;
                    ldsw<u32x4>(sV + row * 528 + cc * 16, tv[i]); ldsw<u32x4>(sR + row * 528 + cc * 16, tr[i]); }
                if (ft < 384) ldsw<float>(tbl + ft * 4, ptab);
                __builtin_amdgcn_sched_barrier(0);
                if (n + 1 < 16) { S3_FETCH(t0 + 64, uc + 1) }
            }
            __syncthreads();
#pragma unroll
            for (int bi = 0; bi < 2; ++bi) {
                const int bb = 2 * w + bi, ib = bb >> 2, jb = bb & 3;
                f32x4 c = {0.f, 0.f, 0.f, 0.f};
                if (jb <= ib) {
                    const lchar* qa = sQ + (16 * ib + fr) * 272 + fq * 16; const lchar* ka = sK + (16 * jb + fr) * 272 + fq * 16;
#pragma unroll
                    for (int ks = 0; ks < 4; ++ks) c = mfma16(ldsr<bf16x8>(ka + ks * 64), ldsr<bf16x8>(qa + ks * 64), c);
                    if (jb == ib) {
#pragma unroll
                        for (int e = 0; e < 4; ++e) if (4 * fq + e > fr) c[e] = 0.f;
                    }
                }
                u32x2 wv = {cvt_pk(c[0], c[1]), cvt_pk(c[2], c[3])};
                ldsw<u32x2>(sP + (16 * ib + fr) * 144 + (16 * jb + 4 * fq) * 2, wv);
            }
            __syncthreads();
            bf16x8 av[4], pfr[8];
#pragma unroll
            for (int ks = 0; ks < 4; ++ks) av[ks] = cat8(tr16(vtr + 16 * ks * 528), tr16(vtr + (16 * ks + 4) * 528));
#pragma unroll
            for (int ks = 0; ks < 4; ++ks)
#pragma unroll
                for (int nb = 0; nb < 2; ++nb) pfr[2 * ks + nb] = ldsr<bf16x8>(prd + 32 * nb * 144 + 32 * ks);
            f32x16 oT[2];
#pragma unroll
            for (int i = 0; i < 2; ++i)
#pragma unroll
                for (int r = 0; r < 16; ++r) oT[i][r] = 0.f;
            f32x4 mA[4], mB[4]; bf16x8 qA[4], qB[4];
#define S3_LDI(M, Q, mb) { _Pragma("unroll") for (int s = 0; s < 2; ++s) { \
                M[2 * s] = ldsr<f32x4>(tb + 512 + (32 * (mb) + 16 * s) * 4); M[2 * s + 1] = ldsr<f32x4>(tb + 512 + (32 * (mb) + 16 * s + 8) * 4); \
                _Pragma("unroll") for (int nb = 0; nb < 2; ++nb) { const lchar* qp = qrd + 32 * nb * 272 + (32 * (mb) + 16 * s) * 2; Q[2 * s + nb] = cat8(ldsr<s16x4>(qp), ldsr<s16x4>(qp + 16)); } } }
#define S3_MMI(M, Q, mb) { _Pragma("unroll") for (int s = 0; s < 2; ++s) { \
                u32x4 sw = {cvt_pk(S[mb][8 * s + 0] * M[2 * s][0], S[mb][8 * s + 1] * M[2 * s][1]), cvt_pk(S[mb][8 * s + 2] * M[2 * s][2], S[mb][8 * s + 3] * M[2 * s][3]), \
                            cvt_pk(S[mb][8 * s + 4] * M[2 * s + 1][0], S[mb][8 * s + 5] * M[2 * s + 1][1]), cvt_pk(S[mb][8 * s + 6] * M[2 * s + 1][2], S[mb][8 * s + 7] * M[2 * s + 1][3])}; \
                const bf16x8 sa = __builtin_bit_cast(bf16x8, sw); \
                _Pragma("unroll") for (int nb = 0; nb < 2; ++nb) oT[nb] = mfma32(sa, Q[2 * s + nb], oT[nb]); } }
            __builtin_amdgcn_sched_barrier(0);
#pragma unroll
            for (int ks = 0; ks < 4; ++ks)
#pragma unroll
                for (int nb = 0; nb < 2; ++nb) oT[nb] = mfma32(av[ks], pfr[2 * ks + nb], oT[nb]);
            S3_LDI(mA, qA, 0)
            __builtin_amdgcn_sched_barrier(0);
            S3_LDI(mB, qB, 1) __builtin_amdgcn_sched_barrier(0); S3_MMI(mA, qA, 0) __builtin_amdgcn_sched_barrier(0);
            S3_LDI(mA, qA, 2) __builtin_amdgcn_sched_barrier(0); S3_MMI(mB, qB, 1) __builtin_amdgcn_sched_barrier(0);
            S3_LDI(mB, qB, 3) __builtin_amdgcn_sched_barrier(0); S3_MMI(mA, qA, 2) __builtin_amdgcn_sched_barrier(0);
            bf16x8 kA[4], kB[4];
#define S3_LDK(KF, mb) { _Pragma("unroll") for (int ks = 0; ks < 4; ++ks) KF[ks] = cat8(tr16(ktr + 16 * ks * 272 + 64 * (mb)), tr16(ktr + (16 * ks + 4) * 272 + 64 * (mb))); }
#define S3_UPD(KF, mb) { f32x4 eg_[4], el_[4]; \
                _Pragma("unroll") for (int rg = 0; rg < 4; ++rg) { eg_[rg] = ldsr<f32x4>(tb + (32 * (mb) + 8 * rg) * 4); el_[rg] = ldsr<f32x4>(tb + 1024 + (32 * (mb) + 8 * rg) * 4); } \
                f32x16 U; _Pragma("unroll") for (int r = 0; r < 16; ++r) U[r] = 0.f; \
                _Pragma("unroll") for (int ks = 0; ks < 4; ++ks) U = mfma32(KF[ks], av[ks], U); \
                _Pragma("unroll") for (int rg = 0; rg < 4; ++rg) _Pragma("unroll") for (int e = 0; e < 4; ++e) S[mb][4 * rg + e] = S[mb][4 * rg + e] * eg_[rg][e] + el_[rg][e] * U[4 * rg + e]; \
                asm volatile("" : "+v"(S[mb])); }
            S3_LDK(kA, 0) __builtin_amdgcn_sched_barrier(0); S3_MMI(mB, qB, 3) __builtin_amdgcn_sched_barrier(0);
            S3_LDK(kB, 1) __builtin_amdgcn_sched_barrier(0); S3_UPD(kA, 0) __builtin_amdgcn_sched_barrier(0);
            S3_LDK(kA, 2) __builtin_amdgcn_sched_barrier(0); S3_UPD(kB, 1) __builtin_amdgcn_sched_barrier(0);
            S3_LDK(kB, 3) __builtin_amdgcn_sched_barrier(0); S3_UPD(kA, 2) __builtin_amdgcn_sched_barrier(0);
            S3_UPD(kB, 3) __builtin_amdgcn_sched_barrier(0);
#undef S3_LDI
#undef S3_MMI
#undef S3_LDK
#undef S3_UPD
            float ss0 = 0.f, ss1 = 0.f;
#pragma unroll
            for (int r = 0; r < 16; ++r) { ss0 += oT[0][r] * oT[0][r]; ss1 += oT[1][r] * oT[1][r]; }
            ss0 += __shfl_xor(ss0, 32); ss1 += __shfl_xor(ss1, 32);
            if (hh == 0) { ldsw<float>(redw, ss0); ldsw<float>(redw + 128, ss1); }
            __syncthreads();
            float tot0 = 0.f, tot1 = 0.f;
#pragma unroll
            for (int ww = 0; ww < 8; ++ww) { tot0 += ldsr<float>(redr + ww * 256); tot1 += ldsr<float>(redr + ww * 256 + 128); }
            const float rs0 = rsqrtf(tot0 * (1.0f / 256.0f) + EPSF), rs1 = rsqrtf(tot1 * (1.0f / 256.0f) + EPSF);
            {
                f32x4 gn[4];
                const float* gp = p->gla_out_norm + 32 * w + 4 * hh;
#pragma unroll
                for (int rg = 0; rg < 4; ++rg) gn[rg] = *(const f32x4*)(gp + 8 * rg);
#pragma unroll
                for (int nb = 0; nb < 2; ++nb) {
                    const float rs = nb ? rs1 : rs0;
                    const int lo = (32 * nb + l31) * 528 + (32 * w + 4 * hh) * 2;
#pragma unroll
                    for (int rg = 0; rg < 4; ++rg) {
                        const u32x2 rr = ldsr<u32x2>(sR + lo + 16 * rg);
                        const float v0 = oT[nb][4 * rg + 0] * rs * gn[rg][0] * silu_f(bf_lo(rr[0]));
                        const float v1 = oT[nb][4 * rg + 1] * rs * gn[rg][1] * silu_f(bf_hi(rr[0]));
                        const float v2 = oT[nb][4 * rg + 2] * rs * gn[rg][2] * silu_f(bf_lo(rr[1]));
                        const float v3 = oT[nb][4 * rg + 3] * rs * gn[rg][3] * silu_f(bf_hi(rr[1]));
                        u32x2 wv = {cvt_pk(v0, v1), cvt_pk(v2, v3)};
                        ldsw<u32x2>(sV + lo + 16 * rg, wv);
                    }
                }
                __syncthreads();
                const int ft2 = ftid();
#pragma unroll
                for (int i = 0; i < 4; ++i) { const int id = ft2 + 512 * i, row = id >> 5, cc = id & 31;
                    *(u32x4*)(on + (size_t)(t0 + row) * 1024 + h * 256 + cc * 8) = ldsr<u32x4>(sV + row * 528 + cc * 16); }
            }
        }
    }
}

__device__ __forceinline__ f32x16 zero_f32x16() { f32x16 z;
#pragma unroll
    for (int r = 0; r < 16; ++r) z[r] = 0.f;
    return z; }
#define AT_RPV(F, u) { const lchar* a_ = vtr + 16 * ((u) >> 1) * 400 + 128 * ((u) & 1); \
    F[0] = cat8(tr16(a_), tr16(a_ + 8 * 400)); F[1] = cat8(tr16(a_ + 64), tr16(a_ + 64 + 8 * 400)); }
#define AT_MPV(F, u) { oT[2 * ((u) & 1)] = mfma32(F[0], pb[(u) >> 1], oT[2 * ((u) & 1)]); oT[2 * ((u) & 1) + 1] = mfma32(F[1], pb[(u) >> 1], oT[2 * ((u) & 1) + 1]); }
#define AT_RQK(F, s) { F[0] = ldsr<bf16x8>(krd + 32 * (s)); F[1] = ldsr<bf16x8>(krd + 32 * 400 + 32 * (s)); }
#define AT_MQK(F, s) { sT[0] = mfma32(F[0], qf[s], (s) ? sT[0] : zero_f32x16()); sT[1] = mfma32(F[1], qf[s], (s) ? sT[1] : zero_f32x16()); }
#define AT_STEP(R, M) R __builtin_amdgcn_sched_barrier(0); M __builtin_amdgcn_sched_barrier(0);
#define AT_PRELOAD(B_, H_, QBI_) { const int tp_ = ftid(), lp_ = tp_ & 63; \
    const size_t tok_ = (size_t)(B_) * SEQL + (QBI_) * 256 + 32 * (tp_ >> 6) + (lp_ & 31); \
    _Pragma("unroll") for (int s = 0; s < 12; ++s) qf[s] = *(const bf16x8*)(qcat + tok_ * 1536 + (H_) * 192 + 16 * s + 8 * (lp_ >> 5)); \
    const bf16_t* kb_ = kcat + (size_t)(B_) * SEQL * 192; \
    _Pragma("unroll") for (int i = 0; i < 3; ++i) { const int id = tp_ + 512 * i, row = id / 24, cc = id % 24; \
        pkA[i] = *(const u32x4*)(kb_ + (size_t)row * 192 + cc * 8); pkB[i] = *(const u32x4*)(kb_ + (size_t)row * 192 + cc * 8 + 64 * 192); } }
__device__ __forceinline__ void attn_qblock(const bf16_t* qcat, const bf16_t* kcat, bf16_t* olat, int b, int h, int qbi, lchar* lds,
                                            bf16x8 (&qf)[12], u32x4 (&pkA)[3], u32x4 (&pkB)[3], bool has_next, int nb, int nh, int nqbi) {
    const int tid = ftid(), lane = tid & 63, w = __builtin_amdgcn_readfirstlane(tid >> 6), l31 = lane & 31, hh = lane >> 5;
    const int q0 = qbi * 256, qw0 = q0 + 32 * w, q = qw0 + l31;
    const size_t tokQ = (size_t)b * SEQL + q;
    const int tr_r = 4 * hh + ((lane & 15) >> 2), tr_c = 16 * ((lane >> 4) & 1) + 4 * (lane & 3);
    const lchar* krd0 = opq(lds + l31 * 400 + 16 * hh);
    const lchar* vtr0 = opq(lds + tr_r * 400 + tr_c * 2);
    const int ntiles = 4 * (qbi + 1);
    const bf16_t* kb = kcat + (size_t)b * SEQL * 192;
    float m = -1e30f, l = 0.f;
    f32x16 oT[4];
#pragma unroll
    for (int i = 0; i < 4; ++i)
#pragma unroll
        for (int r = 0; r < 16; ++r) oT[i][r] = 0.f;
    u32x4 pf[3];
    int soffs[3]; const bf16_t* sptr[3];
#pragma unroll
    for (int i = 0; i < 3; ++i) { const int id = tid + 512 * i, row = id / 24, cc = id % 24; soffs[i] = row * 400 + cc * 16; sptr[i] = kb + (size_t)row * 192 + cc * 8; }
    __syncthreads();
#pragma unroll
    for (int i = 0; i < 3; ++i) { ldsw<u32x4>(lds + soffs[i], pkA[i]); ldsw<u32x4>(lds + 25600 + soffs[i], pkB[i]); }
    __syncthreads();
    f32x16 sT[2];
    {
        const lchar* krd = krd0;
        bf16x8 f0[2], f1[2], f2[2], f3[2];
        AT_RQK(f0, 0) AT_RQK(f1, 1) AT_RQK(f2, 2)
        AT_STEP(AT_RQK(f3, 3), AT_MQK(f0, 0)) AT_STEP(AT_RQK(f0, 4), AT_MQK(f1, 1)) AT_STEP(AT_RQK(f1, 5), AT_MQK(f2, 2)) AT_STEP(AT_RQK(f2, 6), AT_MQK(f3, 3))
        AT_STEP(AT_RQK(f3, 7), AT_MQK(f0, 4)) AT_STEP(AT_RQK(f0, 8), AT_MQK(f1, 5)) AT_STEP(AT_RQK(f1, 9), AT_MQK(f2, 6)) AT_STEP(AT_RQK(f2, 10), AT_MQK(f3, 7))
        AT_STEP(AT_RQK(f3, 11), AT_MQK(f0, 8)) AT_STEP(, AT_MQK(f1, 9)) AT_STEP(, AT_MQK(f2, 10)) AT_STEP(, AT_MQK(f3, 11))
    }
    if (w >= 4) __builtin_amdgcn_s_barrier();
    int bcur = 0, bnxt = 25600, bwr = 51200;
    for (int t = 0; t < ntiles; ++t) {
        if (t + 2 < ntiles) {
#pragma unroll
            for (int i = 0; i < 3; ++i) pf[i] = *(const u32x4*)(sptr[i] + (size_t)(t + 2) * 64 * 192);
        }
        const int kbase = t * 64;
        const bool act = kbase <= qw0 + 31;
        const bool actn = (t + 1 < ntiles) && (kbase + 64 <= qw0 + 31);
        bf16x8 pb[4];
        bf16x8 f0[2], f1[2], f2[2], f3[2];
        const lchar* vtr = vtr0 + bcur;
        const lchar* krd = krd0 + bnxt;
        if (act) {
            if (kbase + 63 > qw0) {
#pragma unroll
                for (int mb = 0; mb < 2; ++mb)
#pragma unroll
                    for (int r = 0; r < 16; ++r) { const int key = kbase + 32 * mb + (r & 3) + 8 * (r >> 2) + 4 * hh; if (key > q) sT[mb][r] = -__builtin_inff(); }
            }
            float mx = fmaxf(sT[0][0], sT[1][0]);
#pragma unroll
            for (int r = 1; r < 16; ++r) mx = fmaxf(fmaxf(mx, sT[0][r]), sT[1][r]);
            { auto rr = __builtin_amdgcn_permlane32_swap(__float_as_uint(mx), __float_as_uint(mx), false, false); mx = fmaxf(__uint_as_float(rr[0]), __uint_as_float(rr[1])); }
            if (!__all(mx <= m + 8.0f)) {
                const float mn = fmaxf(m, mx);
                const float alpha = __builtin_amdgcn_exp2f(m - mn);
                m = mn; l *= alpha;
#pragma unroll
                for (int c = 0; c < 4; ++c)
#pragma unroll
                    for (int r = 0; r < 16; ++r) oT[c][r] *= alpha;
            }
            float rs0 = 0.f, rs1 = 0.f;
#pragma unroll
            for (int r = 0; r < 16; ++r) {
                const float e0 = __builtin_amdgcn_exp2f(sT[0][r] - m), e1 = __builtin_amdgcn_exp2f(sT[1][r] - m); sT[0][r] = e0; sT[1][r] = e1;
                rs0 += e0; asm("" : "+v"(rs0)); rs1 += e1; asm("" : "+v"(rs1));
            }
            float rs = rs0 + rs1;
            { auto rr = __builtin_amdgcn_permlane32_swap(__float_as_uint(rs), __float_as_uint(rs), false, false); rs = __uint_as_float(rr[0]) + __uint_as_float(rr[1]); }
            l += rs;
#pragma unroll
            for (int mb = 0; mb < 2; ++mb)
#pragma unroll
                for (int s2 = 0; s2 < 2; ++s2) {
                    u32x4 pw = {cvt_pk(sT[mb][8 * s2 + 0], sT[mb][8 * s2 + 1]), cvt_pk(sT[mb][8 * s2 + 2], sT[mb][8 * s2 + 3]),
                                cvt_pk(sT[mb][8 * s2 + 4], sT[mb][8 * s2 + 5]), cvt_pk(sT[mb][8 * s2 + 6], sT[mb][8 * s2 + 7])};
                    pb[mb * 2 + s2] = __builtin_bit_cast(bf16x8, pw);
                }
        }
        if (act) { AT_RPV(f0, 0) AT_RPV(f1, 1) AT_RPV(f2, 2) }
        __builtin_amdgcn_s_barrier();
        if (act) {
            AT_STEP(AT_RPV(f3, 3), AT_MPV(f0, 0)) AT_STEP(AT_RPV(f0, 4), AT_MPV(f1, 1)) AT_STEP(AT_RPV(f1, 5), AT_MPV(f2, 2)) AT_STEP(AT_RPV(f2, 6), AT_MPV(f3, 3))
            AT_STEP(AT_RPV(f3, 7), AT_MPV(f0, 4)) AT_STEP(AT_RQK(f0, 0), AT_MPV(f1, 5)) AT_STEP(AT_RQK(f1, 1), AT_MPV(f2, 6)) AT_STEP(AT_RQK(f2, 2), AT_MPV(f3, 7))
        }
        if (t + 2 < ntiles) {
#pragma unroll
            for (int i = 0; i < 3; ++i) ldsw<u32x4>(lds + bwr + soffs[i], pf[i]);
        }
        __builtin_amdgcn_sched_barrier(0);
        if (actn) {
            AT_STEP(AT_RQK(f3, 3), AT_MQK(f0, 0)) AT_STEP(AT_RQK(f0, 4), AT_MQK(f1, 1)) AT_STEP(AT_RQK(f1, 5), AT_MQK(f2, 2)) AT_STEP(AT_RQK(f2, 6), AT_MQK(f3, 3))
            AT_STEP(AT_RQK(f3, 7), AT_MQK(f0, 4)) AT_STEP(AT_RQK(f0, 8), AT_MQK(f1, 5)) AT_STEP(AT_RQK(f1, 9), AT_MQK(f2, 6)) AT_STEP(AT_RQK(f2, 10), AT_MQK(f3, 7))
            AT_STEP(AT_RQK(f3, 11), AT_MQK(f0, 8)) AT_STEP(, AT_MQK(f1, 9)) AT_STEP(, AT_MQK(f2, 10)) AT_STEP(, AT_MQK(f3, 11))
        }
        __syncthreads();
        { const int tmp = bcur; bcur = bnxt; bnxt = bwr; bwr = tmp; }
    }
    if (w < 4) __builtin_amdgcn_s_barrier();
    const float il = __builtin_amdgcn_rcpf(l);
    if (has_next) { AT_PRELOAD(nb, nh, nqbi) }
    __builtin_amdgcn_sched_barrier(0);
    {
        lchar* ob = lds + w * 8448;
        lchar* owr = ob + l31 * 264 + 8 * hh;
#pragma unroll
        for (int c = 0; c < 4; ++c)
#pragma unroll
            for (int rg = 0; rg < 4; ++rg) {
                u32x2 wv = {cvt_pk(oT[c][4 * rg + 0] * il, oT[c][4 * rg + 1] * il), cvt_pk(oT[c][4 * rg + 2] * il, oT[c][4 * rg + 3] * il)};
                ldsw<u32x2>(owr + 64 * c + 16 * rg, wv);
            }
        asm volatile("" ::: "memory");
        const lchar* ord = ob + (lane >> 4) * 264 + (lane & 15) * 16;
        bf16_t* og = olat + ((size_t)b * SEQL + qw0 + (lane >> 4)) * 1024 + h * 128 + (lane & 15) * 8;
#pragma unroll
        for (int i = 0; i < 8; ++i) *(u32x4*)(og + (size_t)(4 * i) * 1024) = ldsr<u32x4>(ord + 4 * i * 264);
    }
}
__device__ __forceinline__ void phase_attention(KArgP p, lchar* lds) {
    const bf16_t* qcat = (const bf16_t*)(p->ws + OFF_BIG + BIG_QCAT); const bf16_t* kcat = (const bf16_t*)(p->ws + OFF_BIG + BIG_KCAT);
    bf16_t* olat = (bf16_t*)(p->ws + OFF_BIG + BIG_OLAT);
    bf16x8 qf[12]; u32x4 pkA[3], pkB[3];
    { const int it0 = blockIdx.x; if (it0 < 1024) { AT_PRELOAD(it0 >> 7, (it0 >> 4) & 7, 31 - (it0 & 15)) } }
    for (int it = blockIdx.x; it < 1024; it += gridDim.x) {
        const int b = it >> 7, h = (it >> 4) & 7, pr = it & 15;
        const int it2 = it + (int)gridDim.x; const bool more = it2 < 1024;
        attn_qblock(qcat, kcat, olat, b, h, 31 - pr, lds, qf, pkA, pkB, true, b, h, pr);
        attn_qblock(qcat, kcat, olat, b, h, pr, lds, qf, pkA, pkB, more, it2 >> 7, (it2 >> 4) & 7, 31 - (it2 & 15));
    }
}

__device__ __forceinline__ KArgP load_params() { KArgP k = (KArgP)__builtin_amdgcn_kernarg_segment_ptr(); asm volatile("" : "+s"(k)); return k; }
#define LDS_BYTES 143360
__global__ void __launch_bounds__(512, 2) hybrid_fwd(Params p_karg) {
    extern __shared__ __attribute__((aligned(16))) char smem[];
    if (threadIdx.x == 0) *(uint4*)smem = make_uint4(0u, 0u, 0u, 0u);
    __syncthreads();
    XcdBarrier bar = xcd_barrier_post((unsigned*)p_karg.ws, (volatile LAS unsigned*)smem);
    char* lds = smem + 64;
    lchar* ldl = (lchar*)smem + 64;

    { KArgP p = load_params(); float* R = (float*)(p->ws + OFF_R); bf16_t* HB = (bf16_t*)(p->ws + OFF_HB); char* BIG = p->ws + OFF_BIG; (void)R; (void)HB; (void)BIG;
    phase_weights(p, (float*)lds);
    phase_norm1024<false, false, false>(p->x, nullptr, nullptr, p->attn_norm, HB, nullptr);
    }
    xcd_barrier(bar);
    { KArgP p = load_params(); float* R = (float*)(p->ws + OFF_R); bf16_t* HB = (bf16_t*)(p->ws + OFF_HB); char* BIG = p->ws + OFF_BIG; (void)R; (void)HB; (void)BIG;
    { pg8::DenseProb P; P.init(HB, p->ws + OFF_GLAIN, NTOK, 3072, 1024); EpiBf16Out e{(bf16_t*)BIG, 3072}; pg8::gemm_phase(ldl, P, e); }
    }
    xcd_barrier(bar);
    { KArgP p = load_params(); float* R = (float*)(p->ws + OFF_R); bf16_t* HB = (bf16_t*)(p->ws + OFF_HB); char* BIG = p->ws + OFF_BIG; (void)R; (void)HB; (void)BIG;
    phase_gla_prep(p, ldl);
    }
    xcd_barrier(bar);
    { KArgP p = load_params(); float* R = (float*)(p->ws + OFF_R); bf16_t* HB = (bf16_t*)(p->ws + OFF_HB); char* BIG = p->ws + OFF_BIG; (void)R; (void)HB; (void)BIG;
    phase_gla_s1(p, ldl);
    }
    xcd_barrier(bar);
    { KArgP p = load_params(); float* R = (float*)(p->ws + OFF_R); bf16_t* HB = (bf16_t*)(p->ws + OFF_HB); char* BIG = p->ws + OFF_BIG; (void)R; (void)HB; (void)BIG;
    phase_gla_s3(p, ldl);
    }
    xcd_barrier(bar);
    { KArgP p = load_params(); float* R = (float*)(p->ws + OFF_R); bf16_t* HB = (bf16_t*)(p->ws + OFF_HB); char* BIG = p->ws + OFF_BIG; (void)R; (void)HB; (void)BIG;
    { pg8::DenseProb P; P.init(HB, p->ws + OFF_GLAWO, NTOK, 1024, 1024); EpiResidX<false> e{p->x, (bf16_t*)R, (float*)(p->ws + OFF_ALR)}; pg8::gemm_phase(ldl, P, e); }
    }
    xcd_barrier(bar);
    { KArgP p = load_params(); float* R = (float*)(p->ws + OFF_R); bf16_t* HB = (bf16_t*)(p->ws + OFF_HB); char* BIG = p->ws + OFF_BIG; (void)R; (void)HB; (void)BIG;
    phase_router(p, 0, (const bf16_t*)R, lds);
    }
    xcd_barrier(bar);
    { KArgP p = load_params(); float* R = (float*)(p->ws + OFF_R); bf16_t* HB = (bf16_t*)(p->ws + OFF_HB); char* BIG = p->ws + OFF_BIG; (void)R; (void)HB; (void)BIG;
    phase_expert1(p, 0, (const bf16_t*)R, ldl);
    }
    xcd_barrier(bar);
    { KArgP p = load_params(); float* R = (float*)(p->ws + OFF_R); bf16_t* HB = (bf16_t*)(p->ws + OFF_HB); char* BIG = p->ws + OFF_BIG; (void)R; (void)HB; (void)BIG;
    phase_expert2(p, 0, ldl);
    }
    xcd_barrier(bar);
    { KArgP p = load_params(); float* R = (float*)(p->ws + OFF_R); bf16_t* HB = (bf16_t*)(p->ws + OFF_HB); char* BIG = p->ws + OFF_BIG; (void)R; (void)HB; (void)BIG;
    phase_norm1024<true, false, true, true>(R, R, (const bf16_t*)BIG, p->attn_norm + 1024, nullptr, (float*)(p->ws + OFF_RSTD));
    conv_run(p, 1, (float*)lds);
    }
    xcd_barrier(bar);
    { KArgP p = load_params(); float* R = (float*)(p->ws + OFF_R); bf16_t* HB = (bf16_t*)(p->ws + OFF_HB); char* BIG = p->ws + OFF_BIG; (void)R; (void)HB; (void)BIG;
    { pg8::DenseProb P; P.init(R, p->ws + OFF_MLAIN, NTOK, 512, 1024);
      EpiMlaFused e{HB, (bf16_t*)(BIG + BIG_KCAT), (const float*)(p->ws + OFF_RSTD), (const float2*)(p->ws + OFF_CS), p->mla_q_norm, p->mla_kv_norm}; pg8::gemm_phase(ldl, P, e); }
    }
    xcd_barrier(bar);
    { KArgP p = load_params(); float* R = (float*)(p->ws + OFF_R); bf16_t* HB = (bf16_t*)(p->ws + OFF_HB); char* BIG = p->ws + OFF_BIG; (void)R; (void)HB; (void)BIG;
    { pg8::DenseProb P; P.init(HB, p->ws + OFF_QABS, NTOK, 1536, 256); EpiQ e{(bf16_t*)(BIG + BIG_QCAT), (const float2*)(p->ws + OFF_CS)}; pg8::gemm_phase(ldl, P, e); }
    }
    xcd_barrier(bar);
    { KArgP p = load_params(); float* R = (float*)(p->ws + OFF_R); bf16_t* HB = (bf16_t*)(p->ws + OFF_HB); char* BIG = p->ws + OFF_BIG; (void)R; (void)HB; (void)BIG;
    phase_attention(p, ldl);
    }
    xcd_barrier(bar);
    { KArgP p = load_params(); float* R = (float*)(p->ws + OFF_R); bf16_t* HB = (bf16_t*)(p->ws + OFF_HB); char* BIG = p->ws + OFF_BIG; (void)R; (void)HB; (void)BIG;
    { pg8::DenseProb P; P.init(BIG + BIG_OLAT, p->ws + OFF_UVO, NTOK, 1024, 1024); EpiResidX<true> e{R, (bf16_t*)R, (float*)(p->ws + OFF_ALR)}; pg8::gemm_phase(ldl, P, e); }
    }
    xcd_barrier(bar);
    { KArgP p = load_params(); float* R = (float*)(p->ws + OFF_R); bf16_t* HB = (bf16_t*)(p->ws + OFF_HB); char* BIG = p->ws + OFF_BIG; (void)R; (void)HB; (void)BIG;
    phase_router(p, 1, (const bf16_t*)R, lds);
    }
    xcd_barrier(bar);
    { KArgP p = load_params(); float* R = (float*)(p->ws + OFF_R); bf16_t* HB = (bf16_t*)(p->ws + OFF_HB); char* BIG = p->ws + OFF_BIG; (void)R; (void)HB; (void)BIG;
    phase_expert1(p, 1, (const bf16_t*)R, ldl);
    }
    xcd_barrier(bar);
    { KArgP p = load_params(); float* R = (float*)(p->ws + OFF_R); bf16_t* HB = (bf16_t*)(p->ws + OFF_HB); char* BIG = p->ws + OFF_BIG; (void)R; (void)HB; (void)BIG;
    phase_expert2(p, 1, ldl);
    }
    xcd_barrier(bar);
    { KArgP p = load_params(); float* R = (float*)(p->ws + OFF_R); bf16_t* HB = (bf16_t*)(p->ws + OFF_HB); char* BIG = p->ws + OFF_BIG; (void)R; (void)HB; (void)BIG;
    phase_norm1024<true, true, true>(R, nullptr, (const bf16_t*)BIG, p->final_norm, nullptr, p->out);
    }
}

extern "C" void kernel_launch(void* const* d_in, const int* in_sizes, int n_in, void* d_out, int out_size, void* d_ws, size_t ws_size, hipStream_t stream) {
    (void)in_sizes; (void)n_in; (void)out_size;
    static int grid = 0;
    if (!grid) {
        int dev = 0, cus = 0, per_cu = 0;
        (void)hipGetDevice(&dev);
        (void)hipDeviceGetAttribute(&cus, hipDeviceAttributeMultiprocessorCount, dev);
        (void)hipFuncSetAttribute((const void*)hybrid_fwd, hipFuncAttributeMaxDynamicSharedMemorySize, LDS_BYTES);
        (void)hipOccupancyMaxActiveBlocksPerMultiprocessor(&per_cu, hybrid_fwd, 512, LDS_BYTES);
        grid = cus * (per_cu < 1 ? per_cu : 1);
        if (grid <= 0) { fprintf(stderr, "occupancy query returned 0\n"); grid = 0; return; }
    }
    if (ws_size < WS_NEED) { fprintf(stderr, "workspace too small: %zu < %zu\n", ws_size, (size_t)WS_NEED); return; }
    (void)hipMemsetAsync(d_ws, 0, 65536, stream);
    Params p{};
    p.x = (const float*)d_in[0]; p.pos = (const int*)d_in[1]; p.attn_norm = (const float*)d_in[2]; p.ffn_norm = (const float*)d_in[3]; p.final_norm = (const float*)d_in[4];
    p.gla_w_in = (const float*)d_in[5]; p.gla_w_gate = (const float*)d_in[6]; p.gla_b_gate = (const float*)d_in[7]; p.gla_out_norm = (const float*)d_in[8]; p.gla_w_o = (const float*)d_in[9];
    p.mla_w_in = (const float*)d_in[10]; p.mla_q_norm = (const float*)d_in[11]; p.mla_w_uq = (const float*)d_in[12]; p.mla_kv_norm = (const float*)d_in[13];
    p.mla_w_uk = (const float*)d_in[14]; p.mla_w_uv = (const float*)d_in[15]; p.mla_w_o = (const float*)d_in[16];
    p.moe_w_group = (const float*)d_in[17]; p.moe_w_expert = (const float*)d_in[18]; p.moe_w1 = (const float*)d_in[19]; p.moe_w3 = (const float*)d_in[20]; p.moe_w2 = (const float*)d_in[21];
    p.out = (float*)d_out; p.ws = (char*)d_ws;
    hipLaunchKernelGGL(hybrid_fwd, dim3(grid), dim3(512), LDS_BYTES, stream, p);
}
```

```cpp
#include <hip/hip_runtime.h>
#include <stdint.h>
#include <stdio.h>

typedef unsigned short bf16_t;
typedef short bf16x8 __attribute__((ext_vector_type(8)));
typedef short s16x4 __attribute__((ext_vector_type(4)));
typedef float f32x4 __attribute__((ext_vector_type(4)));
typedef float f32x16 __attribute__((ext_vector_type(16)));
typedef unsigned u32x2 __attribute__((ext_vector_type(2)));
typedef unsigned u32x4 __attribute__((ext_vector_type(4)));

#define XB_TMO      128
#define XB_XCNT(j)  (256  + 64 * (j))
#define XB_XSUB(j)  (1280 + 64 * (j))
#define XB_XGEN(j)  (2304 + 64 * (j))
#define XB_TOP      3328
#define XB_TOPGEN   3392
#define XCD_BAR_WORDS 3456
#define XB_SPIN_CAP (1u << 18)
#define LAS __attribute__((address_space(3)))

__device__ __forceinline__ unsigned xb_ld(unsigned* p)              { return __hip_atomic_load(p, __ATOMIC_RELAXED, __HIP_MEMORY_SCOPE_AGENT); }
__device__ __forceinline__ unsigned xb_add(unsigned* p, unsigned v) { return __hip_atomic_fetch_add(p, v, __ATOMIC_RELAXED, __HIP_MEMORY_SCOPE_AGENT); }
__device__ __forceinline__ unsigned xb_xcc_id() { return (unsigned)__builtin_amdgcn_s_getreg((3 << 11) | 20) & 0xFu; }
#define XB_SPIN(cond, bar) do { unsigned _sp = 0; while (cond) { __builtin_amdgcn_s_sleep(1); \
    if ((++_sp & 255u) == 0u) { if (xb_ld(&(bar)[XB_TMO])) break; if (_sp > XB_SPIN_CAP) { atomicAdd(&(bar)[XB_TMO], 1u); break; } } } } while (0)

struct XcdBarrier { unsigned* bar; unsigned x; volatile LAS unsigned* st; };

__device__ __forceinline__ XcdBarrier xcd_barrier_post(unsigned* bar, volatile LAS unsigned* st) {
    XcdBarrier b; b.bar = bar; b.x = xb_xcc_id(); b.st = st;
    if (threadIdx.x == 0) (void)xb_add(&bar[XB_XCNT(b.x)], 1u);
    return b;
}
__device__ __forceinline__ void xcd_barrier_complete(unsigned* bar, unsigned x, unsigned& nloc, unsigned& nx) {
    const unsigned G = gridDim.x * gridDim.y * gridDim.z;
    unsigned sum, cnt, mine, sp = 0u;
    for (;;) {
        sum = 0u; cnt = 0u; mine = 0u;
#pragma unroll
        for (unsigned j = 0; j < 16; ++j) { const unsigned c = xb_ld(&bar[XB_XCNT(j)]); sum += c; cnt += (c > 0u) ? 1u : 0u; mine = (j == x) ? c : mine; }
        if (sum == G) break;
        __builtin_amdgcn_s_sleep(1);
        if ((++sp & 255u) == 0u) { if (xb_ld(&bar[XB_TMO])) break; if (sp > XB_SPIN_CAP) { atomicAdd(&bar[XB_TMO], 1u); break; } }
    }
    nloc = mine > 0u ? mine : 1u; nx = cnt > 0u ? cnt : 1u;
}
__device__ __forceinline__ void xcd_barrier(const XcdBarrier& b) {
    asm volatile("s_waitcnt vmcnt(0)" ::: "memory");
    __syncthreads();
    if (threadIdx.x == 0) {
        unsigned* bar = b.bar;
        __builtin_amdgcn_s_waitcnt(0);
        unsigned nloc = b.st[0], nx = b.st[1];
        if (nloc == 0u) { xcd_barrier_complete(bar, b.x, nloc, nx); b.st[0] = nloc; b.st[1] = nx; }
        const unsigned old = xb_add(&bar[XB_XSUB(b.x)], 1u);
        const unsigned gen = old / nloc;
        if (old + 1u == (gen + 1u) * nloc) {
            __builtin_amdgcn_fence(__ATOMIC_RELEASE, "agent");
            asm volatile("s_waitcnt vmcnt(0)" ::: "memory");
            const unsigned og = xb_add(&bar[XB_TOP], 1u);
            const unsigned tg = og / nx;
            if (og + 1u == (tg + 1u) * nx) xb_add(&bar[XB_TOPGEN], 1u);
            else XB_SPIN(xb_ld(&bar[XB_TOPGEN]) == tg, bar);
            __builtin_amdgcn_fence(__ATOMIC_ACQUIRE, "agent");
            xb_add(&bar[XB_XGEN(b.x)], 1u);
            asm volatile("s_waitcnt vmcnt(0)" ::: "memory");
        } else {
            XB_SPIN(xb_ld(&bar[XB_XGEN(b.x)]) == gen, bar);
            __builtin_amdgcn_fence(__ATOMIC_ACQUIRE, "agent");
            asm volatile("s_waitcnt vmcnt(0)" ::: "memory");
        }
    }
    __syncthreads();
}

#define NTOK 65536
#define SEQL 8192
#define EPSF 1e-6f

constexpr size_t MB = (size_t)1 << 20;
constexpr size_t OFF_R     = 1 * MB;
constexpr size_t OFF_HB    = 257 * MB;
constexpr size_t OFF_BIG   = 385 * MB;
constexpr size_t OFF_WT    = 769 * MB;
constexpr size_t OFF_GLAIN = OFF_WT;
constexpr size_t OFF_GLAWO = OFF_WT + 7 * MB;
constexpr size_t OFF_MLAIN = OFF_WT + 9 * MB;
constexpr size_t OFF_QABS  = OFF_WT + 10 * MB;
constexpr size_t OFF_UVO   = OFF_WT + 11 * MB;
constexpr size_t OFF_ROUT  = OFF_WT + 13 * MB;
constexpr size_t OFF_MOE13 = 783 * MB;
constexpr size_t OFF_MOE2  = 847 * MB;
constexpr size_t OFF_ALR   = 879 * MB;
constexpr size_t OFF_EG    = 883 * MB;
constexpr size_t OFF_EM    = 885 * MB;
constexpr size_t OFF_EL    = 887 * MB;
constexpr size_t OFF_SLOC  = 889 * MB;
constexpr size_t OFF_DSEG  = 921 * MB;
constexpr size_t OFF_LISTS = 922 * MB;
constexpr size_t OFF_GATES = 938 * MB;
constexpr size_t OFF_CS    = 939 * MB;
constexpr size_t OFF_RSTD  = 955 * MB;
constexpr size_t OFF_LRSTD = OFF_R + 128 * MB;
constexpr size_t OFF_SLOT  = 956 * MB;
constexpr size_t WS_NEED   = 958 * MB;
constexpr size_t BIG_QCAT = 0;
constexpr size_t BIG_KCAT = 192 * MB;
constexpr size_t BIG_OLAT = 216 * MB;
constexpr size_t BIG_TMP  = 216 * MB;
#define CTRL_GCNT 4096

struct Params {
    const float* x; const int* pos; const float* attn_norm; const float* ffn_norm; const float* final_norm;
    const float* gla_w_in; const float* gla_w_gate; const float* gla_b_gate; const float* gla_out_norm; const float* gla_w_o;
    const float* mla_w_in; const float* mla_q_norm; const float* mla_w_uq; const float* mla_kv_norm; const float* mla_w_uk; const float* mla_w_uv; const float* mla_w_o;
    const float* moe_w_group; const float* moe_w_expert; const float* moe_w1; const float* moe_w3; const float* moe_w2;
    float* out; char* ws;
};

typedef const __attribute__((address_space(4))) Params* KArgP;
__device__ __forceinline__ int ftid() { int t = (int)threadIdx.x; asm volatile("" : "+v"(t)); return t; }
__device__ __forceinline__ unsigned cvt_pk(float lo, float hi) { unsigned r; asm("v_cvt_pk_bf16_f32 %0, %1, %2" : "=v"(r) : "v"(lo), "v"(hi)); return r; }
__device__ __forceinline__ float bf_lo(unsigned w) { return __uint_as_float(w << 16); }
__device__ __forceinline__ float bf_hi(unsigned w) { return __uint_as_float(w & 0xffff0000u); }
__device__ __forceinline__ float bf2f(bf16_t v) { return __uint_as_float(((unsigned)v) << 16); }
__device__ __forceinline__ float wave_sum(float v) {
#pragma unroll
    for (int o = 32; o >= 1; o >>= 1) v += __shfl_xor(v, o);
    return v;
}
__device__ __forceinline__ float silu_f(float x) { return x * __builtin_amdgcn_rcpf(1.0f + __expf(-x)); }
typedef LAS s16x4 lds_s16x4;
typedef LAS char lchar;
__device__ __forceinline__ s16x4 tr16(const lchar* p) { return __builtin_amdgcn_ds_read_tr16_b64_v4i16((lds_s16x4*)p); }
__device__ __forceinline__ lchar* opq(lchar* p) { unsigned v = (unsigned)(size_t)p; asm("" : "+v"(v)); return (lchar*)(size_t)v; }
template <class T> __device__ __forceinline__ T ldsr(const lchar* p) { return *(const LAS T*)p; }
template <class T> __device__ __forceinline__ void ldsw(lchar* p, T v) { *(LAS T*)p = v; }
__device__ __forceinline__ bf16x8 cat8(s16x4 a, s16x4 b) { return __builtin_shufflevector(a, b, 0, 1, 2, 3, 4, 5, 6, 7); }
__device__ __forceinline__ f32x16 mfma32(bf16x8 a, bf16x8 b, f32x16 c) { return __builtin_amdgcn_mfma_f32_32x32x16_bf16(a, b, c, 0, 0, 0); }
__device__ __forceinline__ f32x4 mfma16(bf16x8 a, bf16x8 b, f32x4 c) { return __builtin_amdgcn_mfma_f32_16x16x32_bf16(a, b, c, 0, 0, 0); }

struct CvTile { const float* src; const float* kgain; bf16_t* dst; int ld, ldd, mode, which, k0, n0, nvalid, row0; };
constexpr int CV_DENSE_TILES = 73 * 16, CV_MOE_TILES = 64 * 192;
__device__ __forceinline__ CvTile cv_tile(KArgP p, int set, int t) {
    CvTile m; m.kgain = nullptr; m.mode = 0; m.which = 0; m.row0 = 0; m.nvalid = 1 << 20;
    if (set == 0 && t < CV_DENSE_TILES) {
        const int nt = t >> 4; m.k0 = (t & 15) * 64; m.ldd = 1024;
        if (nt < 49) {
            m.ld = 3088; m.dst = (bf16_t*)(p->ws + OFF_GLAIN);
            if (nt < 32)      { m.src = p->gla_w_in;        m.n0 = nt * 64; }
            else if (nt < 48) { m.src = p->gla_w_in + 2064; m.n0 = (nt - 32) * 64; m.row0 = 2048; }
            else              { m.src = p->gla_w_in + 2048; m.n0 = 0; m.row0 = 3072; m.nvalid = 16; }
        } else if (nt < 65)   { m.src = p->gla_w_o; m.ld = 1024; m.dst = (bf16_t*)(p->ws + OFF_GLAWO); m.n0 = (nt - 49) * 64; }
        else                  { m.src = p->mla_w_in; m.ld = 448; m.dst = (bf16_t*)(p->ws + OFF_MLAIN); m.n0 = (nt - 65) * 64; m.nvalid = 448;
                                m.kgain = p->attn_norm + 1024; if (nt - 65 == 6) m.mode = 2; }
        return m;
    }
    const int tm = set == 0 ? t - CV_DENSE_TILES : t, layer = set;
    const int e = tm / 192, r = tm % 192, kind = r >> 6, rr = r & 63;
    if (kind < 2) {
        const float* w1 = p->moe_w1; const float* w3 = p->moe_w3;
        m.src = (kind == 0 ? w1 : w3) + ((size_t)layer * 64 + e) * 1024 * 256; m.ld = 256;
        m.dst = (bf16_t*)(p->ws + OFF_MOE13) + (size_t)e * 512 * 1024; m.ldd = 1024; m.mode = 1; m.which = kind; m.k0 = (rr >> 2) * 64; m.n0 = (rr & 3) * 64;
        m.kgain = p->ffn_norm + layer * 1024;
    } else {
        m.src = p->moe_w2 + ((size_t)layer * 64 + e) * 256 * 1024; m.ld = 1024;
        m.dst = (bf16_t*)(p->ws + OFF_MOE2) + (size_t)e * 1024 * 256; m.ldd = 256; m.k0 = (rr >> 4) * 64; m.n0 = (rr & 15) * 64;
    }
    return m;
}
#define CV_LOAD(V, G0, G1, D) { \
    const bool ok_ = (D).n0 + c < (D).nvalid; const int col_ = ok_ ? (D).n0 + c : 0; \
    const float* gp_ = ((D).kgain ? (D).kgain : p->ffn_norm) + (D).k0 + l7 * 8; const bool hg_ = (D).kgain != nullptr; \
    const float* sp_ = (D).src + (size_t)((D).k0 + kr) * (D).ld + col_; \
    _Pragma("unroll") for (int q = 0; q < 16; ++q) { const f32x4 x_ = *(const f32x4*)(sp_ + (size_t)(4 * q) * (D).ld); V[q] = ok_ ? x_ : f32x4{0.f, 0.f, 0.f, 0.f}; } \
    { const f32x4 a_ = *(const f32x4*)gp_, b_ = *(const f32x4*)(gp_ + 4); const f32x4 one_ = {1.f, 1.f, 1.f, 1.f}; G0 = hg_ ? a_ : one_; G1 = hg_ ? b_ : one_; } }
__device__ __forceinline__ void conv_run(KArgP p, int set, float* tile_all) {
    const int tid = ftid(), lane = tid & 63, wv = tid >> 6, kr = lane >> 4, c = (lane & 15) * 4, l7 = lane & 7, n8 = lane >> 3;
    float* tl = tile_all + wv * (64 * 65);
    const int NT = set == 0 ? CV_DENSE_TILES + CV_MOE_TILES : CV_MOE_TILES, GW = (int)gridDim.x * 8;
    int t = __builtin_amdgcn_readfirstlane((int)blockIdx.x * 8 + wv);
    __syncthreads();
    if (t < NT) {
        CvTile d = cv_tile(p, set, t);
        f32x4 v[16], g0, g1;
        CV_LOAD(v, g0, g1, d)
        for (; t < NT; t += GW) {
#pragma unroll
            for (int q = 0; q < 16; ++q) { float* d_ = tl + (kr + 4 * q) * 65 + c; d_[0] = v[q][0]; d_[1] = v[q][1]; d_[2] = v[q][2]; d_[3] = v[q][3]; }
            const CvTile me = d; const f32x4 h0 = g0, h1 = g1;
            d = cv_tile(p, set, __builtin_amdgcn_readfirstlane(t + GW < NT ? t + GW : t));
            CV_LOAD(v, g0, g1, d)
            asm volatile("" ::: "memory");
            const float* rp = tl + (l7 * 8) * 65 + n8;
            bf16_t* dp = me.dst + me.k0 + l7 * 8;
#pragma unroll
            for (int ps = 0; ps < 8; ++ps) {
                float f[8];
#pragma unroll
                for (int j = 0; j < 8; ++j) f[j] = rp[j * 65 + 8 * ps];
                const u32x4 w = {cvt_pk(f[0] * h0[0], f[1] * h0[1]), cvt_pk(f[2] * h0[2], f[3] * h0[3]), cvt_pk(f[4] * h1[0], f[5] * h1[1]), cvt_pk(f[6] * h1[2], f[7] * h1[3])};
                const int nn = me.n0 + n8 + 8 * ps;
                const int o2 = nn - me.n0;
                const int drow = me.mode == 1 ? ((nn >> 4) * 32 + me.which * 16 + (nn & 15)) : me.mode == 2 ? (me.n0 + ((o2 >> 4) & 1) * 32 + (o2 >> 5) * 16 + (o2 & 15)) : (me.row0 + nn);
                *(u32x4*)(dp + (size_t)drow * me.ldd) = w;
            }
            asm volatile("" ::: "memory");
        }
    }
    __syncthreads();
}
__device__ __forceinline__ void phase_weights(KArgP p, float* tile) {
    conv_run(p, 0, tile);
    const int gtid = blockIdx.x * 512 + ftid(), gstride = gridDim.x * 512;
    {
        bf16_t* br = (bf16_t*)(p->ws + OFF_ROUT);
        for (int i = gtid; i < 2 * 128 * 1024; i += gstride) {
            const int layer = i >> 17, n = (i >> 10) & 127, k = i & 1023;
            float v = 0.f;
            if (n < 8) v = p->moe_w_group[(size_t)layer * 1024 * 8 + k * 8 + n];
            else if (n < 72) v = p->moe_w_expert[(size_t)layer * 1024 * 64 + k * 64 + (n - 8)];
            v *= p->ffn_norm[layer * 1024 + k];
            br[i] = (bf16_t)(cvt_pk(v, 0.f) & 0xffffu);
        }
    }
    {
        bf16_t* bq = (bf16_t*)(p->ws + OFF_QABS);
        {
            const int tq = ftid(), lane = tq & 63;
            for (int task = blockIdx.x * 8 + (tq >> 6); task < 1024 * 4; task += gridDim.x * 8) {
                const int row = task >> 2, i0 = (task & 3) * 64, h = row >> 7, c = row & 127;
                const float* bp = p->mla_w_uk + (size_t)c * 1024 + h * 128;
                const float b0 = bp[lane], b1 = bp[lane + 64];
                float res = 0.f;
                for (int ii = 0; ii < 64; ii += 8) {
                    float s[8];
#pragma unroll
                    for (int j = 0; j < 8; ++j) { const float* ap = p->mla_w_uq + (size_t)(i0 + ii + j) * 1536 + h * 192; s[j] = ap[lane] * b0 + ap[lane + 64] * b1; }
#pragma unroll
                    for (int j = 0; j < 8; ++j) { s[j] = wave_sum(s[j]); if (lane == ii + j) res = s[j]; }
                }
                bq[row * 256 + i0 + lane] = (bf16_t)(cvt_pk(res, 0.f) & 0xffffu);
            }
        }
        for (int idx = 1024 * 256 + gtid; idx < 1536 * 256; idx += gstride) {
            const int row = idx >> 8, i = idx & 255;
            const int rr = row - 1024, tile = rr >> 8, cl = rr & 255, bj = cl >> 7, wcc = (cl >> 5) & 3, half = (cl >> 4) & 1, lo = cl & 15;
            const int head = tile * 4 + 2 * bj + (wcc >> 1), jj = 16 * (wcc & 1) + lo;
            const float s = p->mla_w_uq[(size_t)i * 1536 + head * 192 + 128 + jj + 32 * half];
            bq[idx] = (bf16_t)(cvt_pk(s, 0.f) & 0xffffu);
        }
    }
    {
        bf16_t* bo = (bf16_t*)(p->ws + OFF_UVO);
        const int t2 = 2 * ftid();
        for (int un = blockIdx.x; un < 256; un += gridDim.x) {
            const int h = un >> 5, c0 = (un & 31) * 4;
            const float* wo = p->mla_w_o + (size_t)(h * 128) * 1024 + t2;
            const float* wv = p->mla_w_uv + (size_t)c0 * 1024 + h * 128;
            float2 acc[4] = {{0.f, 0.f}, {0.f, 0.f}, {0.f, 0.f}, {0.f, 0.f}};
#pragma unroll 32
            for (int v = 0; v < 128; ++v) {
                const float2 x = *(const float2*)(wo + (size_t)v * 1024);
#pragma unroll
                for (int k = 0; k < 4; ++k) { const float u = wv[(size_t)k * 1024 + v]; acc[k].x += u * x.x; acc[k].y += u * x.y; }
            }
            u32x2 w0 = {cvt_pk(acc[0].x, acc[1].x), cvt_pk(acc[2].x, acc[3].x)}, w1 = {cvt_pk(acc[0].y, acc[1].y), cvt_pk(acc[2].y, acc[3].y)};
            *(u32x2*)(bo + (size_t)t2 * 1024 + h * 128 + c0) = w0; *(u32x2*)(bo + (size_t)(t2 + 1) * 1024 + h * 128 + c0) = w1;
        }
    }
    {
        float2* cs = (float2*)(p->ws + OFF_CS);
        const float inv = exp2f(-(float)(gtid & 31) * 0.41524101186092f);
        for (int i0 = gtid; i0 < NTOK * 32; i0 += 8 * gstride) {
            int ps[8];
#pragma unroll
            for (int k = 0; k < 8; ++k) { const int i = i0 + k * gstride; ps[k] = i < NTOK * 32 ? p->pos[i >> 5] : 0; }
#pragma unroll
            for (int k = 0; k < 8; ++k) {
                const int i = i0 + k * gstride;
                if (i < NTOK * 32) {
                    const float ang = (float)ps[k] * inv;
                    double rev = (double)ang * 0.15915494309189535;
                    rev = rev - __builtin_rint(rev);
                    const float fr = (float)rev;
                    cs[i] = make_float2(__builtin_amdgcn_cosf(fr), __builtin_amdgcn_sinf(fr));
                }
            }
        }
    }
}

template <bool ADD_Y, bool FINAL, bool SRC_BF, bool RSTD_ONLY = false>
__device__ __forceinline__ void phase_norm1024(const void* src_, void* wb_, const bf16_t* ybuf, const float* gain, bf16_t* dst, float* fout) {
    const int tid_ = ftid(), lane = tid_ & 63, wv = tid_ >> 6;
    f32x4 g[4];
#pragma unroll
    for (int i = 0; i < 4; ++i) g[i] = *(const f32x4*)(gain + lane * 4 + 256 * i);
    for (int row = blockIdx.x * 8 + wv; row < NTOK; row += gridDim.x * 8) {
        f32x4 v[4]; float ss = 0.f;
        if (SRC_BF) {
            const bf16_t* s = (const bf16_t*)src_ + (size_t)row * 1024;
#pragma unroll
            for (int i = 0; i < 4; ++i) { const u32x2 r = *(const u32x2*)(s + lane * 4 + 256 * i); v[i][0] = bf_lo(r[0]); v[i][1] = bf_hi(r[0]); v[i][2] = bf_lo(r[1]); v[i][3] = bf_hi(r[1]); }
        } else {
            const float* s = (const float*)src_ + (size_t)row * 1024;
#pragma unroll
            for (int i = 0; i < 4; ++i) v[i] = *(const f32x4*)(s + lane * 4 + 256 * i);
        }
        if (ADD_Y) {
#pragma unroll
            for (int i = 0; i < 4; ++i) {
                const u32x2 a = *(const u32x2*)(ybuf + (size_t)(2 * row) * 1024 + lane * 4 + 256 * i);
                const u32x2 b = *(const u32x2*)(ybuf + (size_t)(2 * row + 1) * 1024 + lane * 4 + 256 * i);
                v[i][0] += bf_lo(a[0]) + bf_lo(b[0]); v[i][1] += bf_hi(a[0]) + bf_hi(b[0]);
                v[i][2] += bf_lo(a[1]) + bf_lo(b[1]); v[i][3] += bf_hi(a[1]) + bf_hi(b[1]);
            }
            if (!FINAL) {
#pragma unroll
                for (int i = 0; i < 4; ++i) {
                    if (SRC_BF) { u32x2 w = {cvt_pk(v[i][0], v[i][1]), cvt_pk(v[i][2], v[i][3])}; *(u32x2*)((bf16_t*)wb_ + (size_t)row * 1024 + lane * 4 + 256 * i) = w;
                        if (RSTD_ONLY) { v[i][0] = bf_lo(w[0]); v[i][1] = bf_hi(w[0]); v[i][2] = bf_lo(w[1]); v[i][3] = bf_hi(w[1]); } }
                    else *(f32x4*)((float*)wb_ + (size_t)row * 1024 + lane * 4 + 256 * i) = v[i];
                }
            }
        }
#pragma unroll
        for (int i = 0; i < 4; ++i) ss += v[i][0] * v[i][0] + v[i][1] * v[i][1] + v[i][2] * v[i][2] + v[i][3] * v[i][3];
        ss = wave_sum(ss);
        const float rstd = rsqrtf(ss * (1.0f / 1024.0f) + EPSF);
        if (RSTD_ONLY) { if (lane == 0) fout[row] = rstd; continue; }
#pragma unroll
        for (int i = 0; i < 4; ++i) {
            const f32x4 o = v[i] * rstd * g[i];
            if (FINAL) __builtin_nontemporal_store(o, (f32x4*)(fout + (size_t)row * 1024 + lane * 4 + 256 * i));
            else { u32x2 w = {cvt_pk(o[0], o[1]), cvt_pk(o[2], o[3])}; *(u32x2*)(dst + (size_t)row * 1024 + lane * 4 + 256 * i) = w; }
        }
    }
}

__device__ __forceinline__ void phase_mla_post(KArgP p) {
    const bf16_t* tmp = (const bf16_t*)(p->ws + OFF_BIG + BIG_TMP); const float* rstd2 = (const float*)(p->ws + OFF_RSTD);
    bf16_t* cqn = (bf16_t*)(p->ws + OFF_HB); bf16_t* kcat = (bf16_t*)(p->ws + OFF_BIG + BIG_KCAT);
    const float2* cs = (const float2*)(p->ws + OFF_CS);
    const int tid_ = ftid(), lane = tid_ & 63, wv = tid_ >> 6;
    const f32x4 gq = *(const f32x4*)(p->mla_q_norm + lane * 4);
    const float2 gk = *(const float2*)(p->mla_kv_norm + lane * 2);
    for (int g = blockIdx.x * 8 + wv; g < NTOK / 4; g += gridDim.x * 8) {
        u32x2 qr[4]; unsigned kvr[4]; float r2[4]; bf16_t krr[4]; float2 c[4];
#pragma unroll
        for (int j = 0; j < 4; ++j) {
            const int row = 4 * g + j;
            const bf16_t* s = tmp + (size_t)row * 448;
            qr[j] = *(const u32x2*)(s + lane * 4); kvr[j] = *(const unsigned*)(s + 256 + lane * 2); r2[j] = rstd2[row]; krr[j] = s[384 + lane];
            c[j] = cs[(size_t)row * 32 + (lane & 31)];
        }
#pragma unroll
        for (int j = 0; j < 4; ++j) {
            const int row = 4 * g + j;
            const f32x4 q = (f32x4){bf_lo(qr[j][0]), bf_hi(qr[j][0]), bf_lo(qr[j][1]), bf_hi(qr[j][1])} * r2[j];
            const float2 kv = make_float2(bf_lo(kvr[j]) * r2[j], bf_hi(kvr[j]) * r2[j]);
            const float kr = bf2f(krr[j]) * r2[j];
            const float ssq = wave_sum(q[0] * q[0] + q[1] * q[1] + q[2] * q[2] + q[3] * q[3]);
            const float ssk = wave_sum(kv.x * kv.x + kv.y * kv.y);
            const float rq = rsqrtf(ssq * (1.0f / 256.0f) + EPSF), rk = rsqrtf(ssk * (1.0f / 128.0f) + EPSF);
            u32x2 w = {cvt_pk(q[0] * rq * gq[0], q[1] * rq * gq[1]), cvt_pk(q[2] * rq * gq[2], q[3] * rq * gq[3])};
            *(u32x2*)(cqn + (size_t)row * 256 + lane * 4) = w;
            *(unsigned*)(kcat + (size_t)row * 192 + lane * 2) = cvt_pk(kv.x * rk * gk.x, kv.y * rk * gk.y);
            const float other = __shfl_xor(kr, 32);
            const float o = (lane < 32) ? (kr * c[j].x - other * c[j].y) : (kr * c[j].x + other * c[j].y);
            kcat[(size_t)row * 192 + 128 + lane] = (bf16_t)(cvt_pk(o, 0.f) & 0xffffu);
        }
    }
}

template <int N> struct Ptrs { const bf16_t* p[N]; };
template <int WM, int WN, bool A_LDS>
__device__ __forceinline__ void gemm_core(f32x4 (&acc)[4][4], const Ptrs<WM>& ap, const Ptrs<WN>& bp, int nk, char* stage, const char* aL, int ldaLb) {
    static_assert(!A_LDS && WM == 4 && WN == 2, "router shape only");
    (void)aL; (void)ldaLb; (void)nk;
    constexpr int BM = 64 * WM;
    const int tid = ftid(), lane = tid & 63, wid = tid >> 6;
    const int wm = wid / WN, wn = wid % WN, fr = lane & 15, fq = lane >> 4;
    char* sA = stage; char* sB = stage + BM * 144;
    const int soff = (tid >> 3) * 144 + (tid & 7) * 16;
    u32x4 a0[4], b0[2], a1[4], b1[2], a2[4], b2[2];
#define GC_LOAD(RA, RB, kt) { _Pragma("unroll") for (int i = 0; i < 4; ++i) RA[i] = *(const u32x4*)((const char*)ap.p[i] + (size_t)(kt) * 128); \
                              _Pragma("unroll") for (int i = 0; i < 2; ++i) RB[i] = *(const u32x4*)((const char*)bp.p[i] + (size_t)(kt) * 128); }
#define GC_STORE(RA, RB) { _Pragma("unroll") for (int i = 0; i < 4; ++i) *(u32x4*)(sA + soff + i * 9216) = RA[i]; \
                           _Pragma("unroll") for (int i = 0; i < 2; ++i) *(u32x4*)(sB + soff + i * 9216) = RB[i]; }
    const char* aBase = sA + (wm * 64 + fr) * 144 + fq * 16;
    const char* bBase = sB + (wn * 64 + fr) * 144 + fq * 16;
#define GC_MMA() { _Pragma("unroll") for (int ks = 0; ks < 2; ++ks) { bf16x8 af[4], bfr[4]; \
        _Pragma("unroll") for (int m = 0; m < 4; ++m) af[m] = *(const bf16x8*)(aBase + m * 16 * 144 + ks * 64); \
        _Pragma("unroll") for (int n = 0; n < 4; ++n) bfr[n] = *(const bf16x8*)(bBase + n * 16 * 144 + ks * 64); \
        _Pragma("unroll") for (int m = 0; m < 4; ++m) _Pragma("unroll") for (int n = 0; n < 4; ++n) acc[m][n] = mfma16(bfr[n], af[m], acc[m][n]); } }
#define GC_STEP(RA0, RB0, RA1, RB1, kt) { GC_MMA() __syncthreads(); if ((kt) + 1 < 16) GC_STORE(RA1, RB1) if ((kt) + 3 < 16) GC_LOAD(RA0, RB0, (kt) + 3) __syncthreads(); }
    GC_LOAD(a0, b0, 0) GC_LOAD(a1, b1, 1) GC_LOAD(a2, b2, 2)
    GC_STORE(a0, b0)
    __syncthreads();
    GC_STEP(a0, b0, a1, b1, 0) GC_STEP(a1, b1, a2, b2, 1) GC_STEP(a2, b2, a0, b0, 2)
    GC_STEP(a0, b0, a1, b1, 3) GC_STEP(a1, b1, a2, b2, 4) GC_STEP(a2, b2, a0, b0, 5)
    GC_STEP(a0, b0, a1, b1, 6) GC_STEP(a1, b1, a2, b2, 7) GC_STEP(a2, b2, a0, b0, 8)
    GC_STEP(a0, b0, a1, b1, 9) GC_STEP(a1, b1, a2, b2, 10) GC_STEP(a2, b2, a0, b0, 11)
    GC_STEP(a0, b0, a1, b1, 12) GC_STEP(a1, b1, a2, b2, 13) GC_STEP(a2, b2, a0, b0, 14)
    GC_STEP(a0, b0, a1, b1, 15)
#undef GC_LOAD
#undef GC_STORE
#undef GC_MMA
#undef GC_STEP
}
__device__ __forceinline__ void acc_zero(f32x4 (&acc)[4][4]) {
#pragma unroll
    for (int m = 0; m < 4; ++m)
#pragma unroll
        for (int n = 0; n < 4; ++n) acc[m][n] = (f32x4){0.f, 0.f, 0.f, 0.f};
}
namespace pg8 {
constexpr int BM = 256, BK = 64, HALF = 128, HTB = HALF * BK * 2, STAGE_BYTES = 8 * HTB;
__device__ __forceinline__ int lds_byte(int r, int c) { const int st = (r >> 4) * 2 + (c >> 5), rr = r & 15, cc = c & 31, ob = rr * 64 + cc * 2; return st * 1024 + (ob ^ (((ob >> 9) & 1) << 5)); }
__device__ __forceinline__ void stage_rc(int b, int& R, int& C) { const int st = b / 1024, sb = b % 1024, swz = sb ^ (((sb >> 9) & 1) << 5); R = (st >> 1) * 16 + swz / 64; C = (st & 1) * 32 + (swz % 64) / 2; }
struct Unit { int pm, pn, aux; };
__device__ __forceinline__ int perm32(int rho) { const int n = rho >> 4, i = rho & 15; return 8 * (i >> 2) + 4 * n + (i & 3); }
template <class E_> struct is_perm { template <class T> static char t(decltype(&T::PERM)); template <class T> static long t(...); static constexpr bool v = sizeof(t<E_>(0)) == 1; };
template <class E_> struct has_pre { template <class T> static char t(decltype(&T::pre)); template <class T> static long t(...); static constexpr bool v = sizeof(t<E_>(0)) == 1; };
template <class Prob, class Epi>
__device__ __forceinline__ void gemm_phase(lchar* lds, const Prob& P, const Epi& E) {
    const int tid = ftid(), wid = __builtin_amdgcn_readfirstlane(tid >> 6), lane = tid & 63, wr = wid >> 2, wc = wid & 3, fr = lane & 15, fq = lane >> 4;
    const int K = P.K, nt = K / BK;
    int R0, C0, R1, C1; stage_rc(tid * 16, R0, C0); stage_rc(tid * 16 + 8192, R1, C1);
    unsigned voffB[2];
    if constexpr (is_perm<Epi>::v) { voffB[0] = (unsigned)(((R0 & ~31) + perm32(R0 & 31)) * K + C0) * 2u; voffB[1] = (unsigned)(((R1 & ~31) + perm32(R1 & 31)) * K + C1) * 2u; }
    else { voffB[0] = (unsigned)(R0 * K + C0) * 2u; voffB[1] = (unsigned)(R1 * K + C1) * 2u; }
    const size_t hstepB = (size_t)HALF * K * 2;
    const unsigned ldsw = (unsigned)wid * 1024u;
    const int aoff = lds_byte(wr * 64 + fr, fq * 8), boff = lds_byte(wc * 32 + fr, fq * 8);
    const char* Ab = P.A;
#define PG8_SA(b, h) (((b) * 2 + (h)) * HTB)
#define PG8_SB(b, h) ((4 + (b) * 2 + (h)) * HTB)
#define PG8_STAGE_B(bufoff, gbase) do { _Pragma("unroll") for (int _i = 0; _i < 2; ++_i) \
        __builtin_amdgcn_global_load_lds((const unsigned*)((const char*)(gbase) + voffB[_i]), (LAS unsigned*)(lds + (bufoff) + ldsw + _i * 8192), 16, 0, 0); } while (0)
#define PG8_STAGE_A(bufoff, kb, VO, h) do { _Pragma("unroll") for (int _i = 0; _i < 2; ++_i) \
        __builtin_amdgcn_global_load_lds((const unsigned*)(Ab + (kb) + (VO)[h][_i]), (LAS unsigned*)(lds + (bufoff) + ldsw + _i * 8192), 16, 0, 0); } while (0)
#define PG8_LDA(dst, b, h) do { _Pragma("unroll") for (int m = 0; m < 4; ++m) _Pragma("unroll") for (int k = 0; k < 2; ++k) dst[m][k] = *(const LAS bf16x8*)(lds + PG8_SA(b, h) + aoff + m * 2048 + k * 1024); } while (0)
#define PG8_LDB(dst, b, h) do { _Pragma("unroll") for (int n = 0; n < 2; ++n) _Pragma("unroll") for (int k = 0; k < 2; ++k) dst[n][k] = *(const LAS bf16x8*)(lds + PG8_SB(b, h) + boff + n * 2048 + k * 1024); } while (0)
#define PG8_MMA(ai, bj, At, Bt) do { __builtin_amdgcn_s_setprio(1); _Pragma("unroll") for (int m = 0; m < 4; ++m) _Pragma("unroll") for (int n = 0; n < 2; ++n) _Pragma("unroll") for (int k = 0; k < 2; ++k) \
        acc[ai][bj][m][n] = __builtin_amdgcn_mfma_f32_16x16x32_bf16(Bt[n][k], At[m][k], acc[ai][bj][m][n], 0, 0, 0); __builtin_amdgcn_s_setprio(0); } while (0)
#define PG8_WAIT_V(n) asm volatile("s_waitcnt vmcnt(" #n ")" ::: "memory")
#define PG8_WAIT_L(n) asm volatile("s_waitcnt lgkmcnt(" #n ")" ::: "memory")
#define PG8_BAR __builtin_amdgcn_s_barrier()
#define PG8_SCHED __builtin_amdgcn_sched_barrier(0)
    Unit cur, nxt; int ui = 0;
    if (!P.next(0, cur)) return;
    f32x4 acc[2][2][4][2];
#pragma unroll
    for (int a = 0; a < 2; ++a)
#pragma unroll
        for (int b = 0; b < 2; ++b)
#pragma unroll
            for (int m = 0; m < 4; ++m)
#pragma unroll
                for (int n = 0; n < 2; ++n) acc[a][b][m][n] = (f32x4){0.f, 0.f, 0.f, 0.f};
    bf16x8 At[4][2], B0[2][2], B1[2][2];
    unsigned vc[2][2], vn[2][2];
    P.a_off(cur, R0, C0, R1, C1, vc);
    const char* cB = P.b_base(cur);
    if constexpr (has_pre<Epi>::v) E.pre(cur, 0, lds, wid, lane);
    PG8_STAGE_B(PG8_SB(0, 0), cB); PG8_STAGE_B(PG8_SB(0, 1), cB + hstepB); PG8_STAGE_A(PG8_SA(0, 0), (size_t)0, vc, 0); PG8_STAGE_A(PG8_SA(0, 1), (size_t)0, vc, 1);
    if (wr == 1) PG8_BAR;
    PG8_WAIT_V(2); PG8_BAR;
    PG8_STAGE_B(PG8_SB(1, 0), cB + 128); PG8_STAGE_A(PG8_SA(1, 0), (size_t)128, vc, 0); PG8_STAGE_B(PG8_SB(1, 1), cB + hstepB + 128);
    PG8_WAIT_V(6); PG8_BAR;
    for (;;) {
        const bool has_next = P.next(ui + 1, nxt);
        if (has_next) { P.a_off(nxt, R0, C0, R1, C1, vn); if constexpr (has_pre<Epi>::v) E.pre(nxt, (ui + 1) & 3, lds, wid, lane); }
        else { vn[0][0] = vc[0][0]; vn[0][1] = vc[0][1]; vn[1][0] = vc[1][0]; vn[1][1] = vc[1][1]; }
        const char* nB = has_next ? P.b_base(nxt) : cB;
        for (int t = 0; t < nt; t += 2) {
            const bool last = (t == nt - 2);
            const size_t k1 = (size_t)(t + 1) * 128;
            const size_t k2 = last ? (size_t)0 : (size_t)(t + 2) * 128, k3 = k2 + 128;
            const char* b2 = last ? nB : cB + (size_t)(t + 2) * 128; const char* b3 = b2 + 128;
            unsigned s2[2][2];
            s2[0][0] = last ? vn[0][0] : vc[0][0]; s2[0][1] = last ? vn[0][1] : vc[0][1]; s2[1][0] = last ? vn[1][0] : vc[1][0]; s2[1][1] = last ? vn[1][1] : vc[1][1];
            PG8_LDB(B0, 0, 0); PG8_LDB(B1, 0, 1); PG8_SCHED; PG8_LDA(At, 0, 0); PG8_STAGE_A(PG8_SA(1, 1), k1, vc, 1);
            PG8_WAIT_V(8); PG8_WAIT_L(0); PG8_BAR; PG8_MMA(0, 0, At, B0); PG8_MMA(0, 1, At, B1); PG8_BAR; PG8_SCHED;
            PG8_LDA(At, 0, 1); PG8_STAGE_B(PG8_SB(0, 0), b2); PG8_STAGE_B(PG8_SB(0, 1), b2 + hstepB); PG8_STAGE_A(PG8_SA(0, 0), k2, s2, 0);
            PG8_WAIT_V(8); PG8_WAIT_L(0); PG8_BAR; PG8_MMA(1, 0, At, B0); PG8_MMA(1, 1, At, B1); PG8_BAR; PG8_SCHED;
            PG8_LDB(B0, 1, 0); PG8_LDB(B1, 1, 1); PG8_SCHED; PG8_LDA(At, 1, 0); PG8_STAGE_A(PG8_SA(0, 1), k2, s2, 1);
            PG8_WAIT_V(8); PG8_WAIT_L(0); PG8_BAR; PG8_MMA(0, 0, At, B0); PG8_MMA(0, 1, At, B1); PG8_BAR; PG8_SCHED;
            PG8_LDA(At, 1, 1); PG8_STAGE_B(PG8_SB(1, 0), b3); PG8_STAGE_B(PG8_SB(1, 1), b3 + hstepB); PG8_STAGE_A(PG8_SA(1, 0), k3, s2, 0);
            PG8_WAIT_V(8); PG8_WAIT_L(0); PG8_BAR; PG8_MMA(1, 0, At, B0); PG8_MMA(1, 1, At, B1); PG8_BAR; PG8_SCHED;
        }
        if (wr == 0) PG8_BAR;
        if constexpr (has_pre<Epi>::v) E.run(acc, cur, wr, wc, fr, fq, lds, ui & 3); else E(acc, cur, wr, wc, fr, fq);
        if (!has_next) break;
#pragma unroll
        for (int a = 0; a < 2; ++a)
#pragma unroll
            for (int b = 0; b < 2; ++b)
#pragma unroll
                for (int m = 0; m < 4; ++m)
#pragma unroll
                    for (int n = 0; n < 2; ++n) acc[a][b][m][n] = (f32x4){0.f, 0.f, 0.f, 0.f};
        cur = nxt; cB = nB; vc[0][0] = vn[0][0]; vc[0][1] = vn[0][1]; vc[1][0] = vn[1][0]; vc[1][1] = vn[1][1]; ++ui;
        if (wr == 1) PG8_BAR;
    }
    PG8_WAIT_V(0);
    PG8_BAR;
#undef PG8_SA
#undef PG8_SB
#undef PG8_STAGE_A
#undef PG8_STAGE_B
#undef PG8_LDA
#undef PG8_LDB
#undef PG8_MMA
#undef PG8_WAIT_V
#undef PG8_WAIT_L
#undef PG8_BAR
#undef PG8_SCHED
}
struct DenseProb {
    const char* A; const char* Bt; int K, nM, nN, nwg, G, c;
    __device__ __forceinline__ void init(const void* A_, const void* Bt_, int M, int N, int K_) { A = (const char*)A_; Bt = (const char*)Bt_; K = K_; nM = M / BM; nN = N / BM; nwg = nM * nN; G = (int)gridDim.x; c = (int)blockIdx.x; }
    __device__ __forceinline__ bool next(int i, Unit& u) const {
        const long L = (long)i * G + c; if (L >= nwg) return false;
        int wgid = (int)L; { const int q = nwg / 8, r = nwg % 8, xcd = wgid % 8, off = wgid / 8; wgid = (xcd < r ? xcd * (q + 1) : r * (q + 1) + (xcd - r) * q) + off; }
        const int nig = 8 * nN, gid = wgid / nig, fm = gid * 8, gsz = (nM - fm) < 8 ? (nM - fm) : 8;
        u.pm = fm + ((wgid % nig) % gsz); u.pn = (wgid % nig) / gsz; u.aux = 0; return true;
    }
    __device__ __forceinline__ void a_off(const Unit& u, int R0, int C0, int R1, int C1, unsigned (&v)[2][2]) const {
#pragma unroll
        for (int h = 0; h < 2; ++h) { v[h][0] = (unsigned)((u.pm * BM + HALF * h + R0) * K + C0) * 2u; v[h][1] = (unsigned)((u.pm * BM + HALF * h + R1) * K + C1) * 2u; }
    }
    __device__ __forceinline__ const char* b_base(const Unit& u) const { return Bt + (size_t)u.pn * BM * K * 2; }
};
}

#define PG8_EPI_LOOP(...) _Pragma("unroll") for (int ai = 0; ai < 2; ++ai) _Pragma("unroll") for (int m = 0; m < 4; ++m) { const int row = u.pm * 256 + ai * 128 + wr * 64 + m * 16 + fr; \
        _Pragma("unroll") for (int bj = 0; bj < 2; ++bj) _Pragma("unroll") for (int n = 0; n < 2; ++n) { const int col = u.pn * 256 + bj * 128 + wc * 32 + n * 16 + fq * 4; const f32x4 v = acc[ai][bj][m][n]; __VA_ARGS__ } }
struct EpiBf16Out {
    static constexpr bool PERM = true;
    bf16_t* dst; int ld;
    __device__ __forceinline__ void operator()(const f32x4 (&acc)[2][2][4][2], const pg8::Unit& u, int wr, int wc, int fr, int fq) const {
#pragma unroll
        for (int ai = 0; ai < 2; ++ai)
#pragma unroll
            for (int m = 0; m < 4; ++m) {
                bf16_t* rowp = dst + (size_t)(u.pm * 256 + ai * 128 + wr * 64 + m * 16 + fr) * ld + u.pn * 256 + wc * 32 + 8 * fq;
#pragma unroll
                for (int bj = 0; bj < 2; ++bj) {
                    const f32x4 v0 = acc[ai][bj][m][0], v1 = acc[ai][bj][m][1];
                    u32x4 w = {cvt_pk(v0[0], v0[1]), cvt_pk(v0[2], v0[3]), cvt_pk(v1[0], v1[1]), cvt_pk(v1[2], v1[3])};
                    *(u32x4*)(rowp + bj * 128) = w;
                }
            }
    }
};
struct EpiResid {
    const float* base; float* dst;
    __device__ __forceinline__ void operator()(const f32x4 (&acc)[2][2][4][2], const pg8::Unit& u, int wr, int wc, int fr, int fq) const {
#pragma unroll
        for (int ai = 0; ai < 2; ++ai)
#pragma unroll
            for (int mh = 0; mh < 2; ++mh) {
                f32x4 bs[2][2][2];
#pragma unroll
                for (int mm = 0; mm < 2; ++mm)
#pragma unroll
                    for (int bj = 0; bj < 2; ++bj)
#pragma unroll
                        for (int n = 0; n < 2; ++n) bs[mm][bj][n] = *(const f32x4*)(base + (size_t)(u.pm * 256 + ai * 128 + wr * 64 + (2 * mh + mm) * 16 + fr) * 1024 + u.pn * 256 + bj * 128 + wc * 32 + n * 16 + fq * 4);
#pragma unroll
                for (int mm = 0; mm < 2; ++mm)
#pragma unroll
                    for (int bj = 0; bj < 2; ++bj)
#pragma unroll
                        for (int n = 0; n < 2; ++n) *(f32x4*)(dst + (size_t)(u.pm * 256 + ai * 128 + wr * 64 + (2 * mh + mm) * 16 + fr) * 1024 + u.pn * 256 + bj * 128 + wc * 32 + n * 16 + fq * 4) = bs[mm][bj][n] + acc[ai][bj][2 * mh + mm][n];
            }
    }
};
template <bool BASE_BF> struct EpiResidX {
    const void* base; bf16_t* xb; float* part;
    __device__ __forceinline__ void operator()(const f32x4 (&acc)[2][2][4][2], const pg8::Unit& u, int wr, int wc, int fr, int fq) const {
#pragma unroll
        for (int ai = 0; ai < 2; ++ai) {
            f32x4 bs[4][2][2];
#pragma unroll
            for (int m = 0; m < 4; ++m)
#pragma unroll
                for (int bj = 0; bj < 2; ++bj)
#pragma unroll
                    for (int n = 0; n < 2; ++n) {
                        const size_t o = (size_t)(u.pm * 256 + ai * 128 + wr * 64 + m * 16 + fr) * 1024 + u.pn * 256 + bj * 128 + wc * 32 + n * 16 + fq * 4;
                        if (BASE_BF) { const u32x2 r = *(const u32x2*)((const bf16_t*)base + o); bs[m][bj][n] = (f32x4){bf_lo(r[0]), bf_hi(r[0]), bf_lo(r[1]), bf_hi(r[1])}; }
                        else bs[m][bj][n] = *(const f32x4*)((const float*)base + o);
                    }
#pragma unroll
            for (int m = 0; m < 4; ++m) {
                const int row = u.pm * 256 + ai * 128 + wr * 64 + m * 16 + fr;
                float ss = 0.f;
#pragma unroll
                for (int bj = 0; bj < 2; ++bj)
#pragma unroll
                    for (int n = 0; n < 2; ++n) {
                        const f32x4 v = bs[m][bj][n] + acc[ai][bj][m][n];
                        const size_t o = (size_t)row * 1024 + u.pn * 256 + bj * 128 + wc * 32 + n * 16 + fq * 4;
                        u32x2 w = {cvt_pk(v[0], v[1]), cvt_pk(v[2], v[3])}; *(u32x2*)(xb + o) = w;
                        const float r0 = bf_lo(w[0]), r1 = bf_hi(w[0]), r2 = bf_lo(w[1]), r3 = bf_hi(w[1]);
                        ss += r0 * r0 + r1 * r1 + r2 * r2 + r3 * r3;
                    }
                ss += __shfl_xor(ss, 16); ss += __shfl_xor(ss, 32);
                if (fq == 0) part[(size_t)row * 16 + u.pn * 4 + wc] = ss;
            }
        }
    }
};
#define EPIY_TAB (pg8::STAGE_BYTES + 1024)
struct EpiMlaFused {
    bf16_t* cqn; bf16_t* kcat; const float* rstd2; const float2* cs; const float* gq; const float* gk;
    __device__ __forceinline__ void pre(const pg8::Unit&, int, lchar*, int, int) const {}
    __device__ __forceinline__ void run(const f32x4 (&acc)[2][2][4][2], const pg8::Unit& u, int wr, int wc, int fr, int fq, lchar* lds, int) const {
        LAS float* part = (LAS float*)(lds + EPIY_TAB);
        float r2[2][4];
#pragma unroll
        for (int ai = 0; ai < 2; ++ai)
#pragma unroll
            for (int m = 0; m < 4; ++m) r2[ai][m] = rstd2[u.pm * 256 + ai * 128 + wr * 64 + m * 16 + fr];
        const int nbj = u.pn == 0 ? 2 : 1;
#pragma unroll
        for (int ai = 0; ai < 2; ++ai)
#pragma unroll
            for (int m = 0; m < 4; ++m) {
                float s = 0.f;
#pragma unroll
                for (int bj = 0; bj < 2; ++bj)
#pragma unroll
                    for (int n = 0; n < 2; ++n) { const f32x4 v = acc[ai][bj][m][n] * r2[ai][m]; const float q = v[0] * v[0] + v[1] * v[1] + v[2] * v[2] + v[3] * v[3]; s += (bj < nbj) ? q : 0.f; }
                s += __shfl_xor(s, 16); s += __shfl_xor(s, 32);
                if (fq == 0) part[(ai * 128 + wr * 64 + m * 16 + fr) * 4 + wc] = s;
            }
        asm volatile("s_waitcnt lgkmcnt(0)" ::: "memory");
        __builtin_amdgcn_s_barrier();
        asm volatile("" ::: "memory");
        float rn[2][4];
#pragma unroll
        for (int ai = 0; ai < 2; ++ai)
#pragma unroll
            for (int m = 0; m < 4; ++m) {
                const f32x4 pp = *(const LAS f32x4*)(part + (ai * 128 + wr * 64 + m * 16 + fr) * 4);
                const float tot = (pp[0] + pp[1]) + (pp[2] + pp[3]);
                rn[ai][m] = rsqrtf(tot * (u.pn == 0 ? (1.0f / 256.0f) : (1.0f / 128.0f)) + EPSF) * r2[ai][m];
            }
        if (u.pn == 0) {
            f32x4 g[2][2];
#pragma unroll
            for (int bj = 0; bj < 2; ++bj)
#pragma unroll
                for (int n = 0; n < 2; ++n) g[bj][n] = *(const f32x4*)(gq + bj * 128 + wc * 32 + n * 16 + fq * 4);
#pragma unroll
            for (int ai = 0; ai < 2; ++ai)
#pragma unroll
                for (int m = 0; m < 4; ++m) {
                    bf16_t* rowp = cqn + (size_t)(u.pm * 256 + ai * 128 + wr * 64 + m * 16 + fr) * 256 + wc * 32 + fq * 4;
#pragma unroll
                    for (int bj = 0; bj < 2; ++bj)
#pragma unroll
                        for (int n = 0; n < 2; ++n) { const f32x4 o = acc[ai][bj][m][n] * rn[ai][m] * g[bj][n]; u32x2 w = {cvt_pk(o[0], o[1]), cvt_pk(o[2], o[3])}; *(u32x2*)(rowp + bj * 128 + n * 16) = w; }
                }
        } else {
            f32x4 g[2];
#pragma unroll
            for (int n = 0; n < 2; ++n) g[n] = *(const f32x4*)(gk + wc * 32 + n * 16 + fq * 4);
            const int j0 = wc * 16 + fq * 4;
#pragma unroll
            for (int ai = 0; ai < 2; ++ai) {
                f32x4 cA[4], cB[4];
#pragma unroll
                for (int m = 0; m < 4; ++m) {
                    const f32x4* cp = (const f32x4*)(cs + (size_t)(u.pm * 256 + ai * 128 + wr * 64 + m * 16 + fr) * 32 + (wc < 2 ? j0 : 0)); cA[m] = cp[0]; cB[m] = cp[1];
                }
#pragma unroll
                for (int m = 0; m < 4; ++m) {
                    const size_t row = (size_t)(u.pm * 256 + ai * 128 + wr * 64 + m * 16 + fr);
#pragma unroll
                    for (int n = 0; n < 2; ++n) { const f32x4 o = acc[ai][0][m][n] * rn[ai][m] * g[n]; u32x2 w = {cvt_pk(o[0], o[1]), cvt_pk(o[2], o[3])}; *(u32x2*)(kcat + row * 192 + wc * 32 + n * 16 + fq * 4) = w; }
                    if (wc < 2) {
                        const f32x4 t1 = acc[ai][1][m][0] * r2[ai][m], t2 = acc[ai][1][m][1] * r2[ai][m];
                        const float cx[4] = {cA[m][0], cA[m][2], cB[m][0], cB[m][2]}, cy[4] = {cA[m][1], cA[m][3], cB[m][1], cB[m][3]};
                        f32x4 o1, o2;
#pragma unroll
                        for (int e = 0; e < 4; ++e) { o1[e] = t1[e] * cx[e] - t2[e] * cy[e]; o2[e] = t2[e] * cx[e] + t1[e] * cy[e]; }
                        u32x2 w1 = {cvt_pk(o1[0], o1[1]), cvt_pk(o1[2], o1[3])}, w2 = {cvt_pk(o2[0], o2[1]), cvt_pk(o2[2], o2[3])};
                        *(u32x2*)(kcat + row * 192 + 128 + j0) = w1; *(u32x2*)(kcat + row * 192 + 160 + j0) = w2;
                    }
                }
            }
        }
    }
};
struct EpiMlaIn {
    bf16_t* tmp;
    __device__ __forceinline__ void operator()(const f32x4 (&acc)[2][2][4][2], const pg8::Unit& u, int wr, int wc, int fr, int fq) const {
        PG8_EPI_LOOP({ if (col < 448) { u32x2 w = {cvt_pk(v[0], v[1]), cvt_pk(v[2], v[3])}; *(u32x2*)(tmp + (size_t)row * 448 + col) = w; } })
    }
};
#define QSCALE (0.07216878364870322f * 1.4426950408889634f)
struct EpiQ {
    bf16_t* qcat; const float2* cs;
    __device__ __forceinline__ void operator()(const f32x4 (&acc)[2][2][4][2], const pg8::Unit& u, int wr, int wc, int fr, int fq) const {
        if (u.pn < 4) {
            PG8_EPI_LOOP({ const f32x4 s = v * QSCALE; u32x2 w = {cvt_pk(s[0], s[1]), cvt_pk(s[2], s[3])};
                           *(u32x2*)(qcat + (size_t)row * 1536 + (col >> 7) * 192 + (col & 127)) = w; })
        } else {
            const int jj = 16 * (wc & 1) + 4 * fq;
#pragma unroll
            for (int ai = 0; ai < 2; ++ai) {
                f32x4 cA[4], cB[4];
#pragma unroll
                for (int m = 0; m < 4; ++m) {
                    const int row = u.pm * 256 + ai * 128 + wr * 64 + m * 16 + fr;
                    const f32x4* cp = (const f32x4*)(cs + (size_t)row * 32 + jj); cA[m] = cp[0]; cB[m] = cp[1];
                }
#pragma unroll
                for (int m = 0; m < 4; ++m) {
                    const int row = u.pm * 256 + ai * 128 + wr * 64 + m * 16 + fr;
                    const float cx[4] = {cA[m][0], cA[m][2], cB[m][0], cB[m][2]}, cy[4] = {cA[m][1], cA[m][3], cB[m][1], cB[m][3]};
#pragma unroll
                    for (int bj = 0; bj < 2; ++bj) {
                        const int head = (u.pn - 4) * 4 + 2 * bj + (wc >> 1);
                        const f32x4 t1 = acc[ai][bj][m][0], t2 = acc[ai][bj][m][1];
                        f32x4 o1, o2;
#pragma unroll
                        for (int e = 0; e < 4; ++e) { o1[e] = (t1[e] * cx[e] - t2[e] * cy[e]) * QSCALE; o2[e] = (t2[e] * cx[e] + t1[e] * cy[e]) * QSCALE; }
                        u32x2 w1 = {cvt_pk(o1[0], o1[1]), cvt_pk(o1[2], o1[3])}, w2 = {cvt_pk(o2[0], o2[1]), cvt_pk(o2[2], o2[3])};
                        bf16_t* dst = qcat + (size_t)row * 1536 + head * 192 + 128 + jj;
                        *(u32x2*)dst = w1; *(u32x2*)(dst + 32) = w2;
                    }
                }
            }
        }
    }
};

__device__ __forceinline__ void phase_router(KArgP p, int layer, const bf16_t* A, char* lds) {
    const float* part = (const float*)(p->ws + OFF_ALR); float* RSTD = (float*)(p->ws + OFF_RSTD);
    const bf16_t* Bt = (const bf16_t*)(p->ws + OFF_ROUT) + (size_t)layer * 128 * 1024;
    unsigned* gcnt = (unsigned*)p->ws + CTRL_GCNT + layer * 64;
    int* lists = (int*)(p->ws + OFF_LISTS); float* gates = (float*)(p->ws + OFF_GATES); float* lrstd = (float*)(p->ws + OFF_LRSTD);
    const int tid = ftid(), lane = tid & 63, wid = tid >> 6, wm = wid >> 1, wn = wid & 1, fr = lane & 15, fq = lane >> 4;
    const int srow = tid >> 3, scc = tid & 7;
    float* lg = (float*)lds;
    int* hist = (int*)(lds + 256 * 81 * 4);
    int* hbase = hist + 64;
    for (int u = blockIdx.x; u < NTOK / 256; u += gridDim.x) {
        Ptrs<4> ap; Ptrs<2> bp;
#pragma unroll
        for (int i = 0; i < 4; ++i) ap.p[i] = A + (size_t)(u * 256 + srow + 64 * i) * 1024 + scc * 8;
#pragma unroll
        for (int i = 0; i < 2; ++i) bp.p[i] = Bt + (size_t)(srow + 64 * i) * 1024 + scc * 8;
        f32x4 acc[4][4]; acc_zero(acc);
        gemm_core<4, 2, false>(acc, ap, bp, 16, lds, nullptr, 0);
#pragma unroll
        for (int mb = 0; mb < 4; ++mb)
#pragma unroll
            for (int nb = 0; nb < 4; ++nb) {
                const int m = wm * 64 + mb * 16 + fr, n = wn * 64 + nb * 16 + fq * 4;
                if (n < 80) {
#pragma unroll
                    for (int e = 0; e < 4; ++e) lg[m * 81 + n + e] = acc[mb][nb][e];
                }
            }
        if (tid < 64) hist[tid] = 0;
        __syncthreads();
        int e1 = 0, e2 = 0, lp1 = 0, lp2 = 0; float g1 = 0.f, g2 = 0.f, rstd_t = 0.f;
        if (tid < 256) {
            const float* l = lg + tid * 81;
            float rstd;
            {
                const f32x4* pp = (const f32x4*)(part + (size_t)(u * 256 + tid) * 16);
                const f32x4 a = pp[0], b = pp[1], c = pp[2], d = pp[3];
                const float ssum = ((a[0] + a[1]) + (a[2] + a[3])) + ((b[0] + b[1]) + (b[2] + b[3])) + ((c[0] + c[1]) + (c[2] + c[3])) + ((d[0] + d[1]) + (d[2] + d[3]));
                rstd = rsqrtf(ssum * (1.0f / 1024.0f) + EPSF);
                RSTD[u * 256 + tid] = rstd; rstd_t = rstd;
            }
            float gm = l[0]; int gs = 0;
#pragma unroll
            for (int j = 1; j < 8; ++j) { const float v = l[j]; if (v > gm) { gm = v; gs = j; } }
            float den = 0.f;
#pragma unroll
            for (int j = 0; j < 8; ++j) den += __expf((l[j] - gm) * rstd);
            const float gw = 1.0f / den;
            const float* el = l + 8 + gs * 8;
            float m1 = el[0]; int i1 = 0;
#pragma unroll
            for (int j = 1; j < 8; ++j) { const float v = el[j]; if (v > m1) { m1 = v; i1 = j; } }
            float m2 = -3.0e38f; int i2 = 0;
#pragma unroll
            for (int j = 0; j < 8; ++j) { const float v = el[j]; if (j != i1 && v > m2) { m2 = v; i2 = j; } }
            const float p2 = __expf((m2 - m1) * rstd), inv = 1.0f / (1.0f + p2);
            g1 = gw * inv; g2 = gw * p2 * inv;
            e1 = gs * 8 + i1; e2 = gs * 8 + i2;
            lp1 = atomicAdd(&hist[e1], 1); lp2 = atomicAdd(&hist[e2], 1);
        }
        __syncthreads();
        if (tid < 64) { const int c = hist[tid]; hbase[tid] = c ? (int)atomicAdd(&gcnt[tid], (unsigned)c) : 0; }
        __syncthreads();
        if (tid < 256) {
            const int t = u * 256 + tid;
            lists[(size_t)e1 * 65536 + hbase[e1] + lp1] = 2 * t; lrstd[(size_t)e1 * 65536 + hbase[e1] + lp1] = rstd_t;
            lists[(size_t)e2 * 65536 + hbase[e2] + lp2] = 2 * t + 1; lrstd[(size_t)e2 * 65536 + hbase[e2] + lp2] = rstd_t;
            gates[2 * t] = g1; gates[2 * t + 1] = g2;
        }
        __syncthreads();
    }
}

struct ExpTables { LAS int* pre; LAS int* cnt; LAS int* b2e; };
__device__ __forceinline__ ExpTables expert_tables(KArgP p, int layer, lchar* lds) {
    ExpTables t; t.pre = (LAS int*)(lds + pg8::STAGE_BYTES); t.cnt = t.pre + 72; t.b2e = (LAS int*)(lds + pg8::STAGE_BYTES + 9216);
    const unsigned* gcnt = (const unsigned*)p->ws + CTRL_GCNT + layer * 64;
    __syncthreads();
    const int tx = ftid();
    if (tx < 64) t.cnt[tx] = (int)gcnt[tx];
    __syncthreads();
    if (tx < 64) {
        const int nb = (t.cnt[tx] + 255) >> 8;
        int inc = nb;
#pragma unroll
        for (int o = 1; o < 64; o <<= 1) { const int v = __shfl_up(inc, o); if (tx >= o) inc += v; }
        const int start = inc - nb;
        t.pre[tx] = start; if (tx == 63) t.pre[64] = inc;
        for (int rb = start; rb < inc; ++rb) t.b2e[rb] = tx;
    }
    __syncthreads();
    return t;
}
template <bool GATHER> struct ExpProb {
    const char* A; const char* Bt; int K, nN, nblk, G, c; size_t estride; ExpTables tb; const int* lists;
    __device__ __forceinline__ bool next(int i, pg8::Unit& u) const {
        const int j = c >> 3, R = (G >> 3) / nN * 8;
        const int rb = i * R + (c & 7) + 8 * (j / nN);
        if (j / nN >= (G >> 3) / nN || rb >= nblk) return false;
        u.pm = rb; u.pn = j % nN; u.aux = tb.b2e[rb]; return true;
    }
    __device__ __forceinline__ void a_off(const pg8::Unit& u, int R0, int C0, int R1, int C1, unsigned (&v)[2][2]) const {
        if constexpr (GATHER) {
            const int e = u.aux, j0 = (u.pm - tb.pre[e]) * 256, cn = tb.cnt[e];
#pragma unroll
            for (int h = 0; h < 2; ++h) {
                int i0 = j0 + 128 * h + R0, i1 = j0 + 128 * h + R1; i0 = i0 < cn ? i0 : j0; i1 = i1 < cn ? i1 : j0;
                const int t0 = lists[(size_t)e * 65536 + i0] >> 1, t1 = lists[(size_t)e * 65536 + i1] >> 1;
                v[h][0] = (unsigned)(t0 * 1024 + C0) * 2u; v[h][1] = (unsigned)(t1 * 1024 + C1) * 2u;
            }
        } else {
#pragma unroll
            for (int h = 0; h < 2; ++h) { v[h][0] = (unsigned)((u.pm * 256 + 128 * h + R0) * K + C0) * 2u; v[h][1] = (unsigned)((u.pm * 256 + 128 * h + R1) * K + C1) * 2u; }
        }
    }
    __device__ __forceinline__ const char* b_base(const pg8::Unit& u) const { return Bt + (size_t)u.aux * estride + (size_t)u.pn * 256 * K * 2; }
};
struct EpiHid {
    bf16_t* hid; ExpTables tb; const int* lists; const float* rstd;
    __device__ __forceinline__ void operator()(const f32x4 (&acc)[2][2][4][2], const pg8::Unit& u, int wr, int wc, int fr, int fq) const {
        const int e = u.aux, j0 = (u.pm - tb.pre[e]) * 256, cn = tb.cnt[e];
        float rr[2][4];
#pragma unroll
        for (int ai = 0; ai < 2; ++ai)
#pragma unroll
            for (int m = 0; m < 4; ++m) { const int idx = j0 + ai * 128 + wr * 64 + m * 16 + fr; rr[ai][m] = rstd[(size_t)e * 65536 + (idx < cn ? idx : j0)]; }
#pragma unroll
        for (int ai = 0; ai < 2; ++ai)
#pragma unroll
            for (int m = 0; m < 4; ++m) {
                const int row = u.pm * 256 + ai * 128 + wr * 64 + m * 16 + fr; const float r = rr[ai][m];
#pragma unroll
                for (int bj = 0; bj < 2; ++bj) {
                    const f32x4 a1 = acc[ai][bj][m][0] * r, a3 = acc[ai][bj][m][1] * r;
                    const f32x4 ex = a1 * -1.4426950408889634f;
                    f32x4 d = {__builtin_amdgcn_exp2f(ex[0]), __builtin_amdgcn_exp2f(ex[1]), __builtin_amdgcn_exp2f(ex[2]), __builtin_amdgcn_exp2f(ex[3])};
                    d = d + 1.0f;
                    const f32x4 rc = {__builtin_amdgcn_rcpf(d[0]), __builtin_amdgcn_rcpf(d[1]), __builtin_amdgcn_rcpf(d[2]), __builtin_amdgcn_rcpf(d[3])};
                    const f32x4 o = a1 * rc * a3;
                    u32x2 w = {cvt_pk(o[0], o[1]), cvt_pk(o[2], o[3])};
                    *(u32x2*)(hid + (size_t)row * 256 + u.pn * 128 + bj * 64 + wc * 16 + 4 * fq) = w;
                }
            }
    }
};
struct EpiY {
    static constexpr bool PERM = true;
    bf16_t* ybuf; const int* slot_aid; const float* slot_gate;
    __device__ __forceinline__ void pre(const pg8::Unit& u, int par, lchar* lds, int wid, int lane) const {
        if (wid < 2) {
            const char* src = (wid == 0 ? (const char*)slot_aid : (const char*)slot_gate) + (size_t)u.pm * 1024 + lane * 16;
            __builtin_amdgcn_global_load_lds((const unsigned*)src, (LAS unsigned*)(lds + EPIY_TAB + par * 2048 + wid * 1024), 16, 0, 0);
        }
    }
    __device__ __forceinline__ void run(const f32x4 (&acc)[2][2][4][2], const pg8::Unit& u, int wr, int wc, int fr, int fq, lchar* lds, int par) const {
        const lchar* tab = lds + EPIY_TAB + par * 2048 + (wr * 64 + fr) * 4;
#pragma unroll
        for (int ai = 0; ai < 2; ++ai)
#pragma unroll
            for (int m = 0; m < 4; ++m) {
                const int a = ldsr<int>(tab + (ai * 128 + m * 16) * 4); const float g = ldsr<float>(tab + 1024 + (ai * 128 + m * 16) * 4);
                if (a >= 0) {
#pragma unroll
                    for (int bj = 0; bj < 2; ++bj) {
                        const f32x4 v0 = acc[ai][bj][m][0] * g, v1 = acc[ai][bj][m][1] * g;
                        u32x4 w = {cvt_pk(v0[0], v0[1]), cvt_pk(v0[2], v0[3]), cvt_pk(v1[0], v1[1]), cvt_pk(v1[2], v1[3])};
                        *(u32x4*)(ybuf + (size_t)a * 1024 + u.pn * 256 + bj * 128 + wc * 32 + 8 * fq) = w;
                    }
                }
            }
    }
};
#define BIG_HID (256 * MB)
__device__ __forceinline__ void phase_expert1(KArgP p, int layer, const bf16_t* xb, lchar* lds) {
    ExpProb<true> P; P.tb = expert_tables(p, layer, lds);
    P.A = (const char*)xb; P.Bt = p->ws + OFF_MOE13; P.K = 1024; P.nN = 2; P.nblk = P.tb.pre[64]; P.G = (int)gridDim.x; P.c = (int)blockIdx.x; P.estride = (size_t)512 * 1024 * 2;
    P.lists = (const int*)(p->ws + OFF_LISTS);
    {
        int* slot_aid = (int*)(p->ws + OFF_SLOT); float* slot_gate = (float*)(p->ws + OFF_SLOT + MB);
        const float* gates = (const float*)(p->ws + OFF_GATES);
        const int nsl = P.tb.pre[64] * 256;
        for (int sl = blockIdx.x * 512 + ftid(); sl < nsl; sl += gridDim.x * 512) {
            const int rb = sl >> 8, e = P.tb.b2e[rb];
            const int idx = (rb - P.tb.pre[e]) * 256 + (sl & 255);
            int a = -1; float g = 0.f;
            if (idx < P.tb.cnt[e]) { a = P.lists[(size_t)e * 65536 + idx]; g = gates[a]; }
            slot_aid[sl] = a; slot_gate[sl] = g;
        }
    }
    EpiHid E{(bf16_t*)(p->ws + OFF_BIG + BIG_HID), P.tb, P.lists, (const float*)(p->ws + OFF_LRSTD)};
    pg8::gemm_phase(lds, P, E);
}
__device__ __forceinline__ void phase_expert2(KArgP p, int layer, lchar* lds) {
    ExpProb<false> P; P.tb = expert_tables(p, layer, lds);
    P.A = p->ws + OFF_BIG + BIG_HID; P.Bt = p->ws + OFF_MOE2; P.K = 256; P.nN = 4; P.nblk = P.tb.pre[64]; P.G = (int)gridDim.x; P.c = (int)blockIdx.x; P.estride = (size_t)1024 * 256 * 2;
    P.lists = (const int*)(p->ws + OFF_LISTS);
    EpiY E{(bf16_t*)(p->ws + OFF_BIG), (const int*)(p->ws + OFF_SLOT), (const float*)(p->ws + OFF_SLOT + MB)};
    pg8::gemm_phase(lds, P, E);
}

__device__ __forceinline__ float log_sigmoid_f(float z) { return fminf(z, 0.f) - __logf(1.0f + __expf(-fabsf(z))); }
__device__ __forceinline__ void phase_gla_prep(KArgP p, lchar* lds) {
    bf16_t* proj = (bf16_t*)(p->ws + OFF_BIG);
    const bf16_t* HB = (const bf16_t*)(p->ws + OFF_HB);
    const bf16_t* balr = (const bf16_t*)(p->ws + OFF_GLAIN) + (size_t)3072 * 1024;
    float* EG = (float*)(p->ws + OFF_EG); float* EM = (float*)(p->ws + OFF_EM); float* EL = (float*)(p->ws + OFF_EL);
    LAS float* sa = (LAS float*)lds;
    LAS float* sb = (LAS float*)(lds + 4096);
    LAS float* gs = (LAS float*)(lds + 8192);
    const int tid = ftid(), c = tid, lane = tid & 63, w = tid >> 6, fr = lane & 15, fq = lane >> 4;
    typedef float f32x2 __attribute__((ext_vector_type(2)));
    f32x2 wg2[8];
#pragma unroll
    for (int r = 0; r < 8; ++r) wg2[r] = (f32x2){p->gla_w_gate[(2 * r) * 512 + c], p->gla_w_gate[(2 * r + 1) * 512 + c]};
    const float bias = p->gla_b_gate[c];
    for (int u = blockIdx.x; u < NTOK / 64; u += gridDim.x) {
        const int t0 = u * 64;
        __syncthreads();
        {
            f32x4 cacc = {0.f, 0.f, 0.f, 0.f};
            const int wq = w & 3, kh = (w >> 2) * 16;
            const bf16_t* ap = HB + (size_t)(t0 + 16 * wq + fr) * 1024 + fq * 8 + kh * 32; const bf16_t* bp = balr + (size_t)fr * 1024 + fq * 8 + kh * 32;
            bf16x8 af[16], bf_[16];
#pragma unroll
            for (int ks = 0; ks < 16; ++ks) { af[ks] = *(const bf16x8*)(ap + ks * 32); bf_[ks] = *(const bf16x8*)(bp + ks * 32); }
#pragma unroll
            for (int ks = 0; ks < 16; ++ks) cacc = mfma16(bf_[ks], af[ks], cacc);
            *(LAS f32x4*)((w < 4 ? sa : sb) + (16 * wq + fr) * 16 + 4 * fq) = cacc;
        }
        __syncthreads();
        if (tid < 256) *(LAS f32x4*)(sa + tid * 4) = *(LAS f32x4*)(sa + tid * 4) + *(LAS f32x4*)(sb + tid * 4);
        __syncthreads();
        float z[64];
#pragma unroll
        for (int t = 0; t < 64; ++t) {
            f32x2 zz = {bias, 0.f};
#pragma unroll
            for (int q4 = 0; q4 < 4; ++q4) {
                const f32x4 a4 = *(const LAS f32x4*)(sa + t * 16 + 4 * q4);
                zz = __builtin_elementwise_fma((f32x2){a4[0], a4[1]}, wg2[2 * q4], zz);
                zz = __builtin_elementwise_fma((f32x2){a4[2], a4[3]}, wg2[2 * q4 + 1], zz);
            }
            z[t] = zz[0] + zz[1];
        }
        float g = 0.f, gmid = 0.f;
#pragma unroll
        for (int t = 0; t < 64; ++t) { g += log_sigmoid_f(z[t]) * (1.0f / 16.0f); gs[t * 512 + c] = g; if (t == 32) gmid = g; }
        EG[(size_t)u * 512 + c] = __expf(g); EM[(size_t)u * 512 + c] = __expf(gmid); EL[(size_t)u * 512 + c] = __expf(g - gmid);
        u32x4 raw[16];
#pragma unroll
        for (int i = 0; i < 16; ++i) { const int id = tid + 512 * i, t = id >> 7, cc = id & 127; raw[i] = *(const u32x4*)(proj + (size_t)(t0 + t) * 3072 + (cc >> 6) * 512 + (cc & 63) * 8); }
        __syncthreads();
        const int which = (tid & 127) >> 6, ch = (tid & 63) * 8;
        const float sl = which ? -1.4426950408889634f : 1.4426950408889634f, ls = which ? 0.f : -3.5f;
        f32x4 mt0, mt1;
        { const f32x4 m0 = *(const LAS f32x4*)(gs + 32 * 512 + ch), m1 = *(const LAS f32x4*)(gs + 32 * 512 + ch + 4);
#pragma unroll
          for (int e = 0; e < 4; ++e) { mt0[e] = ls - m0[e] * sl; mt1[e] = ls - m1[e] * sl; } }
#pragma unroll
        for (int i = 0; i < 16; ++i) {
            const int id = tid + 512 * i, t = id >> 7;
            const f32x4 g0 = *(const LAS f32x4*)(gs + t * 512 + ch), g1 = *(const LAS f32x4*)(gs + t * 512 + ch + 4);
            float f[8];
#pragma unroll
            for (int e = 0; e < 4; ++e) { f[e] = __builtin_amdgcn_exp2f(g0[e] * sl + mt0[e]); f[4 + e] = __builtin_amdgcn_exp2f(g1[e] * sl + mt1[e]); }
            u32x4 o;
            o[0] = cvt_pk(bf_lo(raw[i][0]) * f[0], bf_hi(raw[i][0]) * f[1]); o[1] = cvt_pk(bf_lo(raw[i][1]) * f[2], bf_hi(raw[i][1]) * f[3]);
            o[2] = cvt_pk(bf_lo(raw[i][2]) * f[4], bf_hi(raw[i][2]) * f[5]); o[3] = cvt_pk(bf_lo(raw[i][3]) * f[6], bf_hi(raw[i][3]) * f[7]);
            *(u32x4*)(proj + (size_t)(t0 + t) * 3072 + which * 512 + ch) = o;
        }
    }
}

__device__ __forceinline__ void phase_gla_s1(KArgP p, lchar* lds) {
    const bf16_t* proj = (const bf16_t*)(p->ws + OFF_BIG);
    const float* EG = (const float*)(p->ws + OFF_EG); const float* EL = (const float*)(p->ws + OFF_EL);
    float* SLOC = (float*)(p->ws + OFF_SLOC); float* DSEG = (float*)(p->ws + OFF_DSEG);
    lchar* sK = lds; lchar* sV = lds + 17408; lchar* tbl = lds + 17408 + 33792;
    const int tid = ftid(), lane = tid & 63, w = tid >> 6, hh = lane >> 5;
    const int trrow = 8 * hh + ((lane & 15) >> 2), trcol = 16 * ((lane >> 4) & 1) + 4 * (lane & 3);
    const lchar* vtr = opq(sV + trrow * 528 + (32 * w + trcol) * 2);
    const lchar* ktr = opq(sK + trrow * 272 + trcol * 2);
    const lchar* tb = opq(tbl + 16 * hh);
    for (int u = blockIdx.x; u < 256; u += gridDim.x) {
        const int seg = u & 7, bh = u >> 3, b = bh >> 2, h = bh & 3;
        if (seg == 7) continue;
        f32x16 S[4];
#pragma unroll
        for (int i = 0; i < 4; ++i)
#pragma unroll
            for (int r = 0; r < 16; ++r) S[i][r] = 0.f;
        u32x4 pk[2], pv[4]; float ptab = 0.f;
#define S1_LOAD(n_) do { const int cn_ = seg * 16 + (n_), t0_ = b * SEQL + cn_ * 64, uc_ = b * 128 + cn_; \
            _Pragma("unroll") for (int i = 0; i < 2; ++i) { const int id = tid + 512 * i, row = id >> 4, cc = id & 15; pk[i] = *(const u32x4*)(proj + (size_t)(t0_ + row) * 3072 + 512 + h * 128 + cc * 8); } \
            _Pragma("unroll") for (int i = 0; i < 4; ++i) { const int id = tid + 512 * i, row = id >> 5, cc = id & 31; pv[i] = *(const u32x4*)(proj + (size_t)(t0_ + row) * 3072 + 1024 + h * 256 + cc * 8); } \
            if (tid < 128) ptab = EG[(size_t)uc_ * 512 + h * 128 + tid]; else if (tid < 256) ptab = EL[(size_t)uc_ * 512 + h * 128 + tid - 128]; } while (0)
#define S1_STORE() do { \
            _Pragma("unroll") for (int i = 0; i < 2; ++i) { const int id = tid + 512 * i, row = id >> 4, cc = id & 15; ldsw<u32x4>(sK + row * 272 + cc * 16, pk[i]); } \
            _Pragma("unroll") for (int i = 0; i < 4; ++i) { const int id = tid + 512 * i, row = id >> 5, cc = id & 31; ldsw<u32x4>(sV + row * 528 + cc * 16, pv[i]); } \
            if (tid < 256) ldsw<float>(tbl + tid * 4, ptab); } while (0)
        S1_LOAD(0);
        __syncthreads();
        S1_STORE();
#pragma unroll 1
        for (int n = 0; n < 16; ++n) {
            __syncthreads();
            if (n + 1 < 16) S1_LOAD(n + 1);
            bf16x8 vf[4];
#pragma unroll
            for (int ks = 0; ks < 4; ++ks) vf[ks] = cat8(tr16(vtr + 16 * ks * 528), tr16(vtr + (16 * ks + 4) * 528));
#pragma unroll
            for (int mb = 0; mb < 4; ++mb) {
                f32x16 U;
#pragma unroll
                for (int r = 0; r < 16; ++r) U[r] = 0.f;
#pragma unroll
                for (int ks = 0; ks < 4; ++ks) U = mfma32(cat8(tr16(ktr + 16 * ks * 272 + 64 * mb), tr16(ktr + (16 * ks + 4) * 272 + 64 * mb)), vf[ks], U);
#pragma unroll
                for (int rg = 0; rg < 4; ++rg) {
                    const f32x4 eg = ldsr<f32x4>(tb + (32 * mb + 8 * rg) * 4), el = ldsr<f32x4>(tb + 512 + (32 * mb + 8 * rg) * 4);
#pragma unroll
                    for (int e = 0; e < 4; ++e) S[mb][4 * rg + e] = S[mb][4 * rg + e] * eg[e] + el[e] * U[4 * rg + e];
                }
                asm volatile("" : "+v"(S[mb]));
            }
            if (n + 1 < 16) { __syncthreads(); S1_STORE(); }
        }
        {
            float* dst = SLOC + (((size_t)u * 8 + w) * 64 + lane) * 64;
#pragma unroll
            for (int mb = 0; mb < 4; ++mb)
#pragma unroll
                for (int rg = 0; rg < 4; ++rg) { f32x4 v = {S[mb][4 * rg], S[mb][4 * rg + 1], S[mb][4 * rg + 2], S[mb][4 * rg + 3]}; *(f32x4*)(dst + mb * 16 + rg * 4) = v; }
        }
        if (tid < 128) { float pr = 1.f; for (int n = 0; n < 16; ++n) pr *= EG[(size_t)(b * 128 + seg * 16 + n) * 512 + h * 128 + tid]; DSEG[u * 128 + tid] = pr; }
    }
}
#define S3_FETCH(T0, UC) { const int fx_ = ftid(); \
    { const int sel_ = (fx_ >> 7) < 2 ? (fx_ >> 7) : 2;        \
      ptab = *(const float*)((const char*)EG + (size_t)(UC) * 2048 + h * 512 + (unsigned)(sel_ * (int)(2 * MB) + (fx_ & 127) * 4)); } \
    _Pragma("unroll") for (int i = 0; i < 2; ++i) { const int id = fx_ + 512 * i, row = id >> 4, cc = id & 15; \
        const bf16_t* src_ = proj + (size_t)((T0) + row) * 3072 + h * 128 + cc * 8; tq[i] = *(const u32x4*)src_; tk[i] = *(const u32x4*)(src_ + 512); } \
    _Pragma("unroll") for (int i = 0; i < 4; ++i) { const int id = fx_ + 512 * i, row = id >> 5, cc = id & 31; \
        const bf16_t* vsrc_ = proj + (size_t)((T0) + row) * 3072 + 1024 + h * 256 + cc * 8; tv[i] = *(const u32x4*)vsrc_; tr[i] = *(const u32x4*)(vsrc_ + 1024); } }
__device__ __forceinline__ void phase_gla_s3(KArgP p, lchar* lds) {
    const bf16_t* proj = (const bf16_t*)(p->ws + OFF_BIG);
    const float* EG = (const float*)(p->ws + OFF_EG); const float* EM = (const float*)(p->ws + OFF_EM); const float* EL = (const float*)(p->ws + OFF_EL);
    const float* SLOC = (const float*)(p->ws + OFF_SLOC); const float* DSEG = (const float*)(p->ws + OFF_DSEG);
    bf16_t* on = (bf16_t*)(p->ws + OFF_HB);
    lchar* tbl = lds;
    lchar* sQ = lds + 3584; lchar* sK = sQ + 17408; lchar* sV = sK + 17408; lchar* sP = sV + 33792; lchar* sR = sP + 9216;
    const int tid = ftid(), lane = tid & 63, w = tid >> 6, l31 = lane & 31, hh = lane >> 5, fr = lane & 15, fq = lane >> 4;
    const int trrow = 8 * hh + ((lane & 15) >> 2), trcol = 16 * ((lane >> 4) & 1) + 4 * (lane & 3);
    const lchar* vtr = opq(sV + trrow * 528 + (32 * w + trcol) * 2);
    const lchar* ktr = opq(sK + trrow * 272 + trcol * 2);
    const lchar* tb = opq(tbl + 16 * hh);
    const lchar* prd = opq(sP + l31 * 144 + 16 * hh);
    const lchar* qrd = opq(sQ + l31 * 272 + 8 * hh);
    lchar* redw = opq(tbl + 1536 + (w * 64 + l31) * 4);
    const lchar* redr = opq(tbl + 1536 + l31 * 4);
    for (int u = blockIdx.x; u < 256; u += gridDim.x) {
        const int seg = u & 7, bh = u >> 3, b = bh >> 2, h = bh & 3;
        u32x4 tq[2], tk[2], tv[4], tr[4]; float ptab;
        S3_FETCH(b * SEQL + seg * 16 * 64, b * 128 + seg * 16)
        f32x16 S[4];
#pragma unroll
        for (int i = 0; i < 4; ++i)
#pragma unroll
            for (int r = 0; r < 16; ++r) S[i][r] = 0.f;
        for (int sp = 0; sp < seg; ++sp) {
            const int up = bh * 8 + sp;
            __syncthreads();
            if (tid < 128) ldsw<float>(tbl + tid * 4, DSEG[up * 128 + tid]);
            __syncthreads();
            const float* srcp = SLOC + (((size_t)up * 8 + w) * 64 + lane) * 64;
#pragma unroll
            for (int mb = 0; mb < 4; ++mb)
#pragma unroll
                for (int rg = 0; rg < 4; ++rg) {
                    const f32x4 v = *(const f32x4*)(srcp + mb * 16 + rg * 4), dg = ldsr<f32x4>(tb + (32 * mb + 8 * rg) * 4);
#pragma unroll
                    for (int e = 0; e < 4; ++e) S[mb][4 * rg + e] = S[mb][4 * rg + e] * dg[e] + v[e];
                }
        }
        for (int n = 0; n < 16; ++n) {
            const int cn = seg * 16 + n, t0 = b * SEQL + cn * 64, uc = b * 128 + cn;
            __syncthreads();
            {
                const int ft = ftid();
#pragma unroll
                for (int i = 0; i < 2; ++i) { const int id = ft + 512 * i, row = id >> 4, cc = id & 15;
                    ldsw<u32x4>(sQ + row * 272 + cc * 16, tq[i]); ldsw<u32x4>(sK + row * 272 + cc * 16, tk[i]); }
#pragma unroll
                for (int i = 0; i < 4; ++i) { const int id = ft + 512 * i, row = id >> 5, cc = id & 31;
                    ldsw<u32x4>(sV + row * 528 + cc * 16, tv[i]); ldsw<u32x4>(sR + row * 528 + cc * 16, tr[i]); }
                if (ft < 384) ldsw<float>(tbl + ft * 4, ptab);
                __builtin_amdgcn_sched_barrier(0);
                if (n + 1 < 16) { S3_FETCH(t0 + 64, uc + 1) }
            }
            __syncthreads();
#pragma unroll
            for (int bi = 0; bi < 2; ++bi) {
                const int bb = 2 * w + bi, ib = bb >> 2, jb = bb & 3;
                f32x4 c = {0.f, 0.f, 0.f, 0.f};
                if (jb <= ib) {
                    const lchar* qa = sQ + (16 * ib + fr) * 272 + fq * 16; const lchar* ka = sK + (16 * jb + fr) * 272 + fq * 16;
#pragma unroll
                    for (int ks = 0; ks < 4; ++ks) c = mfma16(ldsr<bf16x8>(ka + ks * 64), ldsr<bf16x8>(qa + ks * 64), c);
                    if (jb == ib) {
#pragma unroll
                        for (int e = 0; e < 4; ++e) if (4 * fq + e > fr) c[e] = 0.f;
                    }
                }
                u32x2 wv = {cvt_pk(c[0], c[1]), cvt_pk(c[2], c[3])};
                ldsw<u32x2>(sP + (16 * ib + fr) * 144 + (16 * jb + 4 * fq) * 2, wv);
            }
            __syncthreads();
            bf16x8 av[4], pfr[8];
#pragma unroll
            for (int ks = 0; ks < 4; ++ks) av[ks] = cat8(tr16(vtr + 16 * ks * 528), tr16(vtr + (16 * ks + 4) * 528));
#pragma unroll
            for (int ks = 0; ks < 4; ++ks)
#pragma unroll
                for (int nb = 0; nb < 2; ++nb) pfr[2 * ks + nb] = ldsr<bf16x8>(prd + 32 * nb * 144 + 32 * ks);
            f32x16 oT[2];
#pragma unroll
            for (int i = 0; i < 2; ++i)
#pragma unroll
                for (int r = 0; r < 16; ++r) oT[i][r] = 0.f;
            f32x4 mA[4], mB[4]; bf16x8 qA[4], qB[4];
#define S3_LDI(M, Q, mb) { _Pragma("unroll") for (int s = 0; s < 2; ++s) { \
                M[2 * s] = ldsr<f32x4>(tb + 512 + (32 * (mb) + 16 * s) * 4); M[2 * s + 1] = ldsr<f32x4>(tb + 512 + (32 * (mb) + 16 * s + 8) * 4); \
                _Pragma("unroll") for (int nb = 0; nb < 2; ++nb) { const lchar* qp = qrd + 32 * nb * 272 + (32 * (mb) + 16 * s) * 2; Q[2 * s + nb] = cat8(ldsr<s16x4>(qp), ldsr<s16x4>(qp + 16)); } } }
#define S3_MMI(M, Q, mb) { _Pragma("unroll") for (int s = 0; s < 2; ++s) { \
                u32x4 sw = {cvt_pk(S[mb][8 * s + 0] * M[2 * s][0], S[mb][8 * s + 1] * M[2 * s][1]), cvt_pk(S[mb][8 * s + 2] * M[2 * s][2], S[mb][8 * s + 3] * M[2 * s][3]), \
                            cvt_pk(S[mb][8 * s + 4] * M[2 * s + 1][0], S[mb][8 * s + 5] * M[2 * s + 1][1]), cvt_pk(S[mb][8 * s + 6] * M[2 * s + 1][2], S[mb][8 * s + 7] * M[2 * s + 1][3])}; \
                const bf16x8 sa = __builtin_bit_cast(bf16x8, sw); \
                _Pragma("unroll") for (int nb = 0; nb < 2; ++nb) oT[nb] = mfma32(sa, Q[2 * s + nb], oT[nb]); } }
            __builtin_amdgcn_sched_barrier(0);
#pragma unroll
            for (int ks = 0; ks < 4; ++ks)
#pragma unroll
                for (int nb = 0; nb < 2; ++nb) oT[nb] = mfma32(av[ks], pfr[2 * ks + nb], oT[nb]);
            S3_LDI(mA, qA, 0)
            __builtin_amdgcn_sched_barrier(0);
            S3_LDI(mB, qB, 1) __builtin_amdgcn_sched_barrier(0); S3_MMI(mA, qA, 0) __builtin_amdgcn_sched_barrier(0);
            S3_LDI(mA, qA, 2) __builtin_amdgcn_sched_barrier(0); S3_MMI(mB, qB, 1) __builtin_amdgcn_sched_barrier(0);
            S3_LDI(mB, qB, 3) __builtin_amdgcn_sched_barrier(0); S3_MMI(mA, qA, 2) __builtin_amdgcn_sched_barrier(0);
            bf16x8 kA[4], kB[4];
#define S3_LDK(KF, mb) { _Pragma("unroll") for (int ks = 0; ks < 4; ++ks) KF[ks] = cat8(tr16(ktr + 16 * ks * 272 + 64 * (mb)), tr16(ktr + (16 * ks + 4) * 272 + 64 * (mb))); }
#define S3_UPD(KF, mb) { f32x4 eg_[4], el_[4]; \
                _Pragma("unroll") for (int rg = 0; rg < 4; ++rg) { eg_[rg] = ldsr<f32x4>(tb + (32 * (mb) + 8 * rg) * 4); el_[rg] = ldsr<f32x4>(tb + 1024 + (32 * (mb) + 8 * rg) * 4); } \
                f32x16 U; _Pragma("unroll") for (int r = 0; r < 16; ++r) U[r] = 0.f; \
                _Pragma("unroll") for (int ks = 0; ks < 4; ++ks) U = mfma32(KF[ks], av[ks], U); \
                _Pragma("unroll") for (int rg = 0; rg < 4; ++rg) _Pragma("unroll") for (int e = 0; e < 4; ++e) S[mb][4 * rg + e] = S[mb][4 * rg + e] * eg_[rg][e] + el_[rg][e] * U[4 * rg + e]; \
                asm volatile("" : "+v"(S[mb])); }
            S3_LDK(kA, 0) __builtin_amdgcn_sched_barrier(0); S3_MMI(mB, qB, 3) __builtin_amdgcn_sched_barrier(0);
            S3_LDK(kB, 1) __builtin_amdgcn_sched_barrier(0); S3_UPD(kA, 0) __builtin_amdgcn_sched_barrier(0);
            S3_LDK(kA, 2) __builtin_amdgcn_sched_barrier(0); S3_UPD(kB, 1) __builtin_amdgcn_sched_barrier(0);
            S3_LDK(kB, 3) __builtin_amdgcn_sched_barrier(0); S3_UPD(kA, 2) __builtin_amdgcn_sched_barrier(0);
            S3_UPD(kB, 3) __builtin_amdgcn_sched_barrier(0);
#undef S3_LDI
#undef S3_MMI
#undef S3_LDK
#undef S3_UPD
            f32x4 gn[4];
            { const float* gp = p->gla_out_norm + 32 * w + 4 * hh;
#pragma unroll
              for (int rg = 0; rg < 4; ++rg) gn[rg] = *(const f32x4*)(gp + 8 * rg); }
            float ss0 = 0.f, ss1 = 0.f;
#pragma unroll
            for (int r = 0; r < 16; ++r) { ss0 += oT[0][r] * oT[0][r]; ss1 += oT[1][r] * oT[1][r]; }
            ss0 += __shfl_xor(ss0, 32); ss1 += __shfl_xor(ss1, 32);
            if (hh == 0) { ldsw<float>(redw, ss0); ldsw<float>(redw + 128, ss1); }
            __syncthreads();
            float tot0 = 0.f, tot1 = 0.f;
#pragma unroll
            for (int ww = 0; ww < 8; ++ww) { tot0 += ldsr<float>(redr + ww * 256); tot1 += ldsr<float>(redr + ww * 256 + 128); }
            const float rs0 = rsqrtf(tot0 * (1.0f / 256.0f) + EPSF), rs1 = rsqrtf(tot1 * (1.0f / 256.0f) + EPSF);
            {
#pragma unroll
                for (int nb = 0; nb < 2; ++nb) {
                    typedef float f2 __attribute__((ext_vector_type(2)));
                    const float rs = nb ? rs1 : rs0;
                    const f2 rs2 = {rs, rs};
                    const int lo = (32 * nb + l31) * 528 + (32 * w + 4 * hh) * 2;
#pragma unroll
                    for (int rg = 0; rg < 4; ++rg) {
                        const u32x2 rr = ldsr<u32x2>(sR + lo + 16 * rg);
                        unsigned wv[2];
#pragma unroll
                        for (int hp = 0; hp < 2; ++hp) {
                            const f2 x = {bf_lo(rr[hp]), bf_hi(rr[hp])};
                            const f2 a = x * (f2){-1.4426950408889634f, -1.4426950408889634f};
                            const f2 d = (f2){__builtin_amdgcn_exp2f(a[0]), __builtin_amdgcn_exp2f(a[1])} + (f2){1.0f, 1.0f};
                            const f2 sg = x * (f2){__builtin_amdgcn_rcpf(d[0]), __builtin_amdgcn_rcpf(d[1])};
                            const f2 o = (f2){oT[nb][4 * rg + 2 * hp], oT[nb][4 * rg + 2 * hp + 1]} * rs2 * (f2){gn[rg][2 * hp], gn[rg][2 * hp + 1]} * sg;
                            wv[hp] = cvt_pk(o[0], o[1]);
                        }
                        ldsw<u32x2>(sV + lo + 16 * rg, (u32x2){wv[0], wv[1]});
                    }
                }
                __syncthreads();
                const int ft2 = ftid();
#pragma unroll
                for (int i = 0; i < 4; ++i) { const int id = ft2 + 512 * i, row = id >> 5, cc = id & 31;
                    *(u32x4*)(on + (size_t)(t0 + row) * 1024 + h * 256 + cc * 8) = ldsr<u32x4>(sV + row * 528 + cc * 16); }
            }
        }
    }
}

__device__ __forceinline__ f32x16 zero_f32x16() { f32x16 z;
#pragma unroll
    for (int r = 0; r < 16; ++r) z[r] = 0.f;
    return z; }
#define AT_RPV(F, u) { const lchar* a_ = vtr + 16 * ((u) >> 1) * 400 + 128 * ((u) & 1); \
    F[0] = cat8(tr16(a_), tr16(a_ + 8 * 400)); F[1] = cat8(tr16(a_ + 64), tr16(a_ + 64 + 8 * 400)); }
#define AT_MPV(F, u) { oT[2 * ((u) & 1)] = mfma32(F[0], pb[(u) >> 1], oT[2 * ((u) & 1)]); oT[2 * ((u) & 1) + 1] = mfma32(F[1], pb[(u) >> 1], oT[2 * ((u) & 1) + 1]); }
#define AT_RQK(F, s) { F[0] = ldsr<bf16x8>(krd + 32 * (s)); F[1] = ldsr<bf16x8>(krd + 32 * 400 + 32 * (s)); }
#define AT_MQK(F, s) { sT[0] = mfma32(F[0], qf[s], (s) ? sT[0] : zero_f32x16()); sT[1] = mfma32(F[1], qf[s], (s) ? sT[1] : zero_f32x16()); }
#define AT_STEP(R, M) R __builtin_amdgcn_sched_barrier(0); M __builtin_amdgcn_sched_barrier(0);
__device__ __forceinline__ void attn_qblock(const bf16_t* qcat, const bf16_t* kcat, bf16_t* olat, int b, int h, int qbi, lchar* lds) {
    const int tid = ftid(), lane = tid & 63, w = __builtin_amdgcn_readfirstlane(tid >> 6), l31 = lane & 31, hh = lane >> 5;
    const int q0 = qbi * 256, qw0 = q0 + 32 * w, q = qw0 + l31;
    const size_t tokQ = (size_t)b * SEQL + q;
    const int tr_r = 4 * hh + ((lane & 15) >> 2), tr_c = 16 * ((lane >> 4) & 1) + 4 * (lane & 3);
    const lchar* krd0 = opq(lds + l31 * 400 + 16 * hh);
    const lchar* vtr0 = opq(lds + tr_r * 400 + tr_c * 2);
    bf16x8 qf[12];
#pragma unroll
    for (int s = 0; s < 12; ++s) qf[s] = *(const bf16x8*)(qcat + tokQ * 1536 + h * 192 + 16 * s + 8 * hh);
    const int ntiles = 4 * (qbi + 1);
    const bf16_t* kb = kcat + (size_t)b * SEQL * 192;
    float m = -1e30f, l = 0.f;
    f32x16 oT[4];
#pragma unroll
    for (int i = 0; i < 4; ++i)
#pragma unroll
        for (int r = 0; r < 16; ++r) oT[i][r] = 0.f;
    u32x4 pf[3];
    int soffs[3]; const bf16_t* sptr[3];
#pragma unroll
    for (int i = 0; i < 3; ++i) { const int id = tid + 512 * i, row = id / 24, cc = id % 24; soffs[i] = row * 400 + cc * 16; sptr[i] = kb + (size_t)row * 192 + cc * 8; }
    __syncthreads();
    {
        u32x4 pg[3];
#pragma unroll
        for (int i = 0; i < 3; ++i) { pf[i] = *(const u32x4*)(sptr[i]); pg[i] = *(const u32x4*)(sptr[i] + 64 * 192); }
#pragma unroll
        for (int i = 0; i < 3; ++i) { ldsw<u32x4>(lds + soffs[i], pf[i]); ldsw<u32x4>(lds + 25600 + soffs[i], pg[i]); }
    }
    __syncthreads();
    f32x16 sT[2];
    {
        const lchar* krd = krd0;
        bf16x8 f0[2], f1[2], f2[2], f3[2];
        AT_RQK(f0, 0) AT_RQK(f1, 1) AT_RQK(f2, 2)
        AT_STEP(AT_RQK(f3, 3), AT_MQK(f0, 0)) AT_STEP(AT_RQK(f0, 4), AT_MQK(f1, 1)) AT_STEP(AT_RQK(f1, 5), AT_MQK(f2, 2)) AT_STEP(AT_RQK(f2, 6), AT_MQK(f3, 3))
        AT_STEP(AT_RQK(f3, 7), AT_MQK(f0, 4)) AT_STEP(AT_RQK(f0, 8), AT_MQK(f1, 5)) AT_STEP(AT_RQK(f1, 9), AT_MQK(f2, 6)) AT_STEP(AT_RQK(f2, 10), AT_MQK(f3, 7))
        AT_STEP(AT_RQK(f3, 11), AT_MQK(f0, 8)) AT_STEP(, AT_MQK(f1, 9)) AT_STEP(, AT_MQK(f2, 10)) AT_STEP(, AT_MQK(f3, 11))
    }
    if (w >= 4) __builtin_amdgcn_s_barrier();
    int bcur = 0, bnxt = 25600, bwr = 51200;
    for (int t = 0; t < ntiles; ++t) {
        if (t + 2 < ntiles) {
#pragma unroll
            for (int i = 0; i < 3; ++i) pf[i] = *(const u32x4*)(sptr[i] + (size_t)(t + 2) * 64 * 192);
        }
        const int kbase = t * 64;
        const bool act = kbase <= qw0 + 31;
        const bool actn = (t + 1 < ntiles) && (kbase + 64 <= qw0 + 31);
        bf16x8 pb[4];
        bf16x8 f0[2], f1[2], f2[2], f3[2];
        const lchar* vtr = vtr0 + bcur;
        const lchar* krd = krd0 + bnxt;
        if (act) {
            if (kbase + 63 > qw0) {
#pragma unroll
                for (int mb = 0; mb < 2; ++mb)
#pragma unroll
                    for (int r = 0; r < 16; ++r) { const int key = kbase + 32 * mb + (r & 3) + 8 * (r >> 2) + 4 * hh; if (key > q) sT[mb][r] = -__builtin_inff(); }
            }
            float mx = fmaxf(sT[0][0], sT[1][0]);
#pragma unroll
            for (int r = 1; r < 16; ++r) mx = fmaxf(fmaxf(mx, sT[0][r]), sT[1][r]);
            { auto rr = __builtin_amdgcn_permlane32_swap(__float_as_uint(mx), __float_as_uint(mx), false, false); mx = fmaxf(__uint_as_float(rr[0]), __uint_as_float(rr[1])); }
            if (!__all(mx <= m + 8.0f)) {
                const float mn = fmaxf(m, mx);
                const float alpha = __builtin_amdgcn_exp2f(m - mn);
                m = mn; l *= alpha;
#pragma unroll
                for (int c = 0; c < 4; ++c)
#pragma unroll
                    for (int r = 0; r < 16; ++r) oT[c][r] *= alpha;
            }
            float rs0 = 0.f, rs1 = 0.f;
#pragma unroll
            for (int r = 0; r < 16; ++r) {
                const float e0 = __builtin_amdgcn_exp2f(sT[0][r] - m), e1 = __builtin_amdgcn_exp2f(sT[1][r] - m); sT[0][r] = e0; sT[1][r] = e1;
                rs0 += e0; asm("" : "+v"(rs0)); rs1 += e1; asm("" : "+v"(rs1));
            }
            float rs = rs0 + rs1;
            { auto rr = __builtin_amdgcn_permlane32_swap(__float_as_uint(rs), __float_as_uint(rs), false, false); rs = __uint_as_float(rr[0]) + __uint_as_float(rr[1]); }
            l += rs;
#pragma unroll
            for (int mb = 0; mb < 2; ++mb)
#pragma unroll
                for (int s2 = 0; s2 < 2; ++s2) {
                    u32x4 pw = {cvt_pk(sT[mb][8 * s2 + 0], sT[mb][8 * s2 + 1]), cvt_pk(sT[mb][8 * s2 + 2], sT[mb][8 * s2 + 3]),
                                cvt_pk(sT[mb][8 * s2 + 4], sT[mb][8 * s2 + 5]), cvt_pk(sT[mb][8 * s2 + 6], sT[mb][8 * s2 + 7])};
                    pb[mb * 2 + s2] = __builtin_bit_cast(bf16x8, pw);
                }
        }
        if (act) { AT_RPV(f0, 0) AT_RPV(f1, 1) AT_RPV(f2, 2) }
        __builtin_amdgcn_s_barrier();
        if (act) {
            AT_STEP(AT_RPV(f3, 3), AT_MPV(f0, 0)) AT_STEP(AT_RPV(f0, 4), AT_MPV(f1, 1)) AT_STEP(AT_RPV(f1, 5), AT_MPV(f2, 2)) AT_STEP(AT_RPV(f2, 6), AT_MPV(f3, 3))
            AT_STEP(AT_RPV(f3, 7), AT_MPV(f0, 4)) AT_STEP(AT_RQK(f0, 0), AT_MPV(f1, 5)) AT_STEP(AT_RQK(f1, 1), AT_MPV(f2, 6)) AT_STEP(AT_RQK(f2, 2), AT_MPV(f3, 7))
        }
        if (t + 2 < ntiles) {
#pragma unroll
            for (int i = 0; i < 3; ++i) ldsw<u32x4>(lds + bwr + soffs[i], pf[i]);
        }
        __builtin_amdgcn_sched_barrier(0);
        if (actn) {
            AT_STEP(AT_RQK(f3, 3), AT_MQK(f0, 0)) AT_STEP(AT_RQK(f0, 4), AT_MQK(f1, 1)) AT_STEP(AT_RQK(f1, 5), AT_MQK(f2, 2)) AT_STEP(AT_RQK(f2, 6), AT_MQK(f3, 3))
            AT_STEP(AT_RQK(f3, 7), AT_MQK(f0, 4)) AT_STEP(AT_RQK(f0, 8), AT_MQK(f1, 5)) AT_STEP(AT_RQK(f1, 9), AT_MQK(f2, 6)) AT_STEP(AT_RQK(f2, 10), AT_MQK(f3, 7))
            AT_STEP(AT_RQK(f3, 11), AT_MQK(f0, 8)) AT_STEP(, AT_MQK(f1, 9)) AT_STEP(, AT_MQK(f2, 10)) AT_STEP(, AT_MQK(f3, 11))
        }
        __syncthreads();
        { const int tmp = bcur; bcur = bnxt; bnxt = bwr; bwr = tmp; }
    }
    if (w < 4) __builtin_amdgcn_s_barrier();
    const float il = __builtin_amdgcn_rcpf(l);
    {
        lchar* ob = lds + w * 8448;
        lchar* owr = ob + l31 * 264 + 8 * hh;
#pragma unroll
        for (int c = 0; c < 4; ++c)
#pragma unroll
            for (int rg = 0; rg < 4; ++rg) {
                u32x2 wv = {cvt_pk(oT[c][4 * rg + 0] * il, oT[c][4 * rg + 1] * il), cvt_pk(oT[c][4 * rg + 2] * il, oT[c][4 * rg + 3] * il)};
                ldsw<u32x2>(owr + 64 * c + 16 * rg, wv);
            }
        asm volatile("" ::: "memory");
        const lchar* ord = ob + (lane >> 4) * 264 + (lane & 15) * 16;
        bf16_t* og = olat + ((size_t)b * SEQL + qw0 + (lane >> 4)) * 1024 + h * 128 + (lane & 15) * 8;
#pragma unroll
        for (int i = 0; i < 8; ++i) *(u32x4*)(og + (size_t)(4 * i) * 1024) = ldsr<u32x4>(ord + 4 * i * 264);
    }
}
__device__ __forceinline__ void phase_attention(KArgP p, lchar* lds) {
    const bf16_t* qcat = (const bf16_t*)(p->ws + OFF_BIG + BIG_QCAT); const bf16_t* kcat = (const bf16_t*)(p->ws + OFF_BIG + BIG_KCAT);
    bf16_t* olat = (bf16_t*)(p->ws + OFF_BIG + BIG_OLAT);
    for (int it = blockIdx.x; it < 1024; it += gridDim.x) {
        const int b = it >> 7, h = (it >> 4) & 7, pr = it & 15;
        attn_qblock(qcat, kcat, olat, b, h, 31 - pr, lds);
        attn_qblock(qcat, kcat, olat, b, h, pr, lds);
    }
}

__device__ __forceinline__ KArgP load_params() { KArgP k = (KArgP)__builtin_amdgcn_kernarg_segment_ptr(); asm volatile("" : "+s"(k)); return k; }
#define LDS_BYTES 143360
__global__ void __launch_bounds__(512, 2) hybrid_fwd(Params p_karg) {
    extern __shared__ __attribute__((aligned(16))) char smem[];
    if (threadIdx.x == 0) *(uint4*)smem = make_uint4(0u, 0u, 0u, 0u);
    __syncthreads();
    XcdBarrier bar = xcd_barrier_post((unsigned*)p_karg.ws, (volatile LAS unsigned*)smem);
    char* lds = smem + 64;
    lchar* ldl = (lchar*)smem + 64;

    { KArgP p = load_params(); float* R = (float*)(p->ws + OFF_R); bf16_t* HB = (bf16_t*)(p->ws + OFF_HB); char* BIG = p->ws + OFF_BIG; (void)R; (void)HB; (void)BIG;
    phase_weights(p, (float*)lds);
    phase_norm1024<false, false, false>(p->x, nullptr, nullptr, p->attn_norm, HB, nullptr);
    }
    xcd_barrier(bar);
    { KArgP p = load_params(); float* R = (float*)(p->ws + OFF_R); bf16_t* HB = (bf16_t*)(p->ws + OFF_HB); char* BIG = p->ws + OFF_BIG; (void)R; (void)HB; (void)BIG;
    { pg8::DenseProb P; P.init(HB, p->ws + OFF_GLAIN, NTOK, 3072, 1024); EpiBf16Out e{(bf16_t*)BIG, 3072}; pg8::gemm_phase(ldl, P, e); }
    }
    xcd_barrier(bar);
    { KArgP p = load_params(); float* R = (float*)(p->ws + OFF_R); bf16_t* HB = (bf16_t*)(p->ws + OFF_HB); char* BIG = p->ws + OFF_BIG; (void)R; (void)HB; (void)BIG;
    phase_gla_prep(p, ldl);
    }
    xcd_barrier(bar);
    { KArgP p = load_params(); float* R = (float*)(p->ws + OFF_R); bf16_t* HB = (bf16_t*)(p->ws + OFF_HB); char* BIG = p->ws + OFF_BIG; (void)R; (void)HB; (void)BIG;
    phase_gla_s1(p, ldl);
    }
    xcd_barrier(bar);
    { KArgP p = load_params(); float* R = (float*)(p->ws + OFF_R); bf16_t* HB = (bf16_t*)(p->ws + OFF_HB); char* BIG = p->ws + OFF_BIG; (void)R; (void)HB; (void)BIG;
    phase_gla_s3(p, ldl);
    }
    xcd_barrier(bar);
    { KArgP p = load_params(); float* R = (float*)(p->ws + OFF_R); bf16_t* HB = (bf16_t*)(p->ws + OFF_HB); char* BIG = p->ws + OFF_BIG; (void)R; (void)HB; (void)BIG;
    { pg8::DenseProb P; P.init(HB, p->ws + OFF_GLAWO, NTOK, 1024, 1024); EpiResidX<false> e{p->x, (bf16_t*)R, (float*)(p->ws + OFF_ALR)}; pg8::gemm_phase(ldl, P, e); }
    }
    xcd_barrier(bar);
    { KArgP p = load_params(); float* R = (float*)(p->ws + OFF_R); bf16_t* HB = (bf16_t*)(p->ws + OFF_HB); char* BIG = p->ws + OFF_BIG; (void)R; (void)HB; (void)BIG;
    phase_router(p, 0, (const bf16_t*)R, lds);
    }
    xcd_barrier(bar);
    { KArgP p = load_params(); float* R = (float*)(p->ws + OFF_R); bf16_t* HB = (bf16_t*)(p->ws + OFF_HB); char* BIG = p->ws + OFF_BIG; (void)R; (void)HB; (void)BIG;
    phase_expert1(p, 0, (const bf16_t*)R, ldl);
    }
    xcd_barrier(bar);
    { KArgP p = load_params(); float* R = (float*)(p->ws + OFF_R); bf16_t* HB = (bf16_t*)(p->ws + OFF_HB); char* BIG = p->ws + OFF_BIG; (void)R; (void)HB; (void)BIG;
    phase_expert2(p, 0, ldl);
    }
    xcd_barrier(bar);
    { KArgP p = load_params(); float* R = (float*)(p->ws + OFF_R); bf16_t* HB = (bf16_t*)(p->ws + OFF_HB); char* BIG = p->ws + OFF_BIG; (void)R; (void)HB; (void)BIG;
    phase_norm1024<true, false, true, true>(R, R, (const bf16_t*)BIG, p->attn_norm + 1024, nullptr, (float*)(p->ws + OFF_RSTD));
    conv_run(p, 1, (float*)lds);
    }
    xcd_barrier(bar);
    { KArgP p = load_params(); float* R = (float*)(p->ws + OFF_R); bf16_t* HB = (bf16_t*)(p->ws + OFF_HB); char* BIG = p->ws + OFF_BIG; (void)R; (void)HB; (void)BIG;
    { pg8::DenseProb P; P.init(R, p->ws + OFF_MLAIN, NTOK, 512, 1024);
      EpiMlaFused e{HB, (bf16_t*)(BIG + BIG_KCAT), (const float*)(p->ws + OFF_RSTD), (const float2*)(p->ws + OFF_CS), p->mla_q_norm, p->mla_kv_norm}; pg8::gemm_phase(ldl, P, e); }
    }
    xcd_barrier(bar);
    { KArgP p = load_params(); float* R = (float*)(p->ws + OFF_R); bf16_t* HB = (bf16_t*)(p->ws + OFF_HB); char* BIG = p->ws + OFF_BIG; (void)R; (void)HB; (void)BIG;
    { pg8::DenseProb P; P.init(HB, p->ws + OFF_QABS, NTOK, 1536, 256); EpiQ e{(bf16_t*)(BIG + BIG_QCAT), (const float2*)(p->ws + OFF_CS)}; pg8::gemm_phase(ldl, P, e); }
    }
    xcd_barrier(bar);
    { KArgP p = load_params(); float* R = (float*)(p->ws + OFF_R); bf16_t* HB = (bf16_t*)(p->ws + OFF_HB); char* BIG = p->ws + OFF_BIG; (void)R; (void)HB; (void)BIG;
    phase_attention(p, ldl);
    }
    xcd_barrier(bar);
    { KArgP p = load_params(); float* R = (float*)(p->ws + OFF_R); bf16_t* HB = (bf16_t*)(p->ws + OFF_HB); char* BIG = p->ws + OFF_BIG; (void)R; (void)HB; (void)BIG;
    { pg8::DenseProb P; P.init(BIG + BIG_OLAT, p->ws + OFF_UVO, NTOK, 1024, 1024); EpiResidX<true> e{R, (bf16_t*)R, (float*)(p->ws + OFF_ALR)}; pg8::gemm_phase(ldl, P, e); }
    }
    xcd_barrier(bar);
    { KArgP p = load_params(); float* R = (float*)(p->ws + OFF_R); bf16_t* HB = (bf16_t*)(p->ws + OFF_HB); char* BIG = p->ws + OFF_BIG; (void)R; (void)HB; (void)BIG;
    phase_router(p, 1, (const bf16_t*)R, lds);
    }
    xcd_barrier(bar);
    { KArgP p = load_params(); float* R = (float*)(p->ws + OFF_R); bf16_t* HB = (bf16_t*)(p->ws + OFF_HB); char* BIG = p->ws + OFF_BIG; (void)R; (void)HB; (void)BIG;
    phase_expert1(p, 1, (const bf16_t*)R, ldl);
    }
    xcd_barrier(bar);
    { KArgP p = load_params(); float* R = (float*)(p->ws + OFF_R); bf16_t* HB = (bf16_t*)(p->ws + OFF_HB); char* BIG = p->ws + OFF_BIG; (void)R; (void)HB; (void)BIG;
    phase_expert2(p, 1, ldl);
    }
    xcd_barrier(bar);
    { KArgP p = load_params(); float* R = (float*)(p->ws + OFF_R); bf16_t* HB = (bf16_t*)(p->ws + OFF_HB); char* BIG = p->ws + OFF_BIG; (void)R; (void)HB; (void)BIG;
    phase_norm1024<true, true, true>(R, nullptr, (const bf16_t*)BIG, p->final_norm, nullptr, p->out);
    }
}

extern "C" void kernel_launch(void* const* d_in, const int* in_sizes, int n_in, void* d_out, int out_size, void* d_ws, size_t ws_size, hipStream_t stream) {
    (void)in_sizes; (void)n_in; (void)out_size;
    static int grid = 0;
    if (!grid) {
        int dev = 0, cus = 0, per_cu = 0;
        (void)hipGetDevice(&dev);
        (void)hipDeviceGetAttribute(&cus, hipDeviceAttributeMultiprocessorCount, dev);
        (void)hipFuncSetAttribute((const void*)hybrid_fwd, hipFuncAttributeMaxDynamicSharedMemorySize, LDS_BYTES);
        (void)hipOccupancyMaxActiveBlocksPerMultiprocessor(&per_cu, hybrid_fwd, 512, LDS_BYTES);
        grid = cus * (per_cu < 1 ? per_cu : 1);
        if (grid <= 0) { fprintf(stderr, "occupancy query returned 0\n"); grid = 0; return; }
    }
    if (ws_size < WS_NEED) { fprintf(stderr, "workspace too small: %zu < %zu\n", ws_size, (size_t)WS_NEED); return; }
    (void)hipMemsetAsync(d_ws, 0, 65536, stream);
    Params p{};
    p.x = (const float*)d_in[0]; p.pos = (const int*)d_in[1]; p.attn_norm = (const float*)d_in[2]; p.ffn_norm = (const float*)d_in[3]; p.final_norm = (const float*)d_in[4];
    p.gla_w_in = (const float*)d_in[5]; p.gla_w_gate = (const float*)d_in[6]; p.gla_b_gate = (const float*)d_in[7]; p.gla_out_norm = (const float*)d_in[8]; p.gla_w_o = (const float*)d_in[9];
    p.mla_w_in = (const float*)d_in[10]; p.mla_q_norm = (const float*)d_in[11]; p.mla_w_uq = (const float*)d_in[12]; p.mla_kv_norm = (const float*)d_in[13];
    p.mla_w_uk = (const float*)d_in[14]; p.mla_w_uv = (const float*)d_in[15]; p.mla_w_o = (const float*)d_in[16];
    p.moe_w_group = (const float*)d_in[17]; p.moe_w_expert = (const float*)d_in[18]; p.moe_w1 = (const float*)d_in[19]; p.moe_w3 = (const float*)d_in[20]; p.moe_w2 = (const float*)d_in[21];
    p.out = (float*)d_out; p.ws = (char*)d_ws;
    hipLaunchKernelGGL(hybrid_fwd, dim3(grid), dim3(512), LDS_BYTES, stream, p);
}
```
